# Optimizing an MI355X kernel written in HIP

```python
import math
import jax
import jax.numpy as jnp
from jax import lax
import numpy as np

D_MODEL = 2048
BATCH = 4
SEQ = 8192
DEPTH = 2

GRID_W = 64
CTX_LEN = 256
EPS = 1e-6
NEG = -1e30
F32 = jnp.float32

ATT_HEADS = 8
ATT_KV_HEADS = 2
ATT_GROUP = ATT_HEADS // ATT_KV_HEADS
HEAD_DIM = 128
ATT_WIDTH = ATT_HEADS * HEAD_DIM
KV_WIDTH = ATT_KV_HEADS * HEAD_DIM
WINDOW = 128
BLOCK = 128
ROPE_BASE = 10000.0

POOL_WINDOWS = (2, 4, 8, 16)
POOL_GROUP = 128
POOL_WIDTH = POOL_GROUP * len(POOL_WINDOWS)

HY_WIDTH = 512
HY_ORDER = 2
HY_PROJ = (HY_ORDER + 1) * HY_WIDTH
HY_SHORT = 3
HY_EMB = 33
HY_BANDS = (HY_EMB - 1) // 2
HY_FILTER_HIDDEN = 64
HY_SHORT_DECAY_PCT = 0.3
HY_LONG_DECAY_PCT = 1.5
HY_TARGET = 1e-2

MIX_WIDTH = ATT_WIDTH + POOL_WIDTH + HY_WIDTH
IN_WIDTH = ATT_WIDTH + 2 * KV_WIDTH + POOL_WIDTH + HY_PROJ

D_FF = 5632
N_EXPERTS = 8
TOP_K = 2
N_DENSE = (DEPTH + 1) // 2
N_MOE = DEPTH // 2

kernel_name = 'hybrid_prefix_dit_block'


def rmsnorm(x, g):
    xf = x.astype(F32)
    y = xf * lax.rsqrt(jnp.mean(xf * xf, axis=-1, keepdims=True) + EPS)
    return (y * g.astype(F32)).astype(x.dtype)


def modulate(h, shift, scale):
    return h * (1.0 + scale[:, None]) + shift[:, None]


def axial_rope_tables(n_tokens):
    rows = n_tokens // GRID_W
    row = jnp.repeat(jnp.arange(rows, dtype=F32), GRID_W)
    col = jnp.tile(jnp.arange(GRID_W, dtype=F32), rows)
    n_freq = HEAD_DIM // 4
    inv = ROPE_BASE ** (-jnp.arange(n_freq, dtype=F32) / n_freq)
    ang_r = row[:, None] * inv
    ang_c = col[:, None] * inv
    return (jnp.cos(ang_r), jnp.sin(ang_r), jnp.cos(ang_c), jnp.sin(ang_c))


def _rotate(x, cos, sin):
    x1, x2 = jnp.split(x, 2, axis=-1)
    cos = cos[:, None, :].astype(x.dtype)
    sin = sin[:, None, :].astype(x.dtype)
    return jnp.concatenate([x1 * cos - x2 * sin, x2 * cos + x1 * sin], axis=-1)


def apply_axial_rope(x, tabs):
    cr, sr, cc, sc = tabs
    half = HEAD_DIM // 2
    return jnp.concatenate([_rotate(x[..., :half], cr, sr), _rotate(x[..., half:], cc, sc)], axis=-1)


def split_proj(p):
    lead = p.shape[:-1]
    o = 0
    q = p[..., o:o + ATT_WIDTH].reshape(lead + (ATT_HEADS, HEAD_DIM))
    o += ATT_WIDTH
    k = p[..., o:o + KV_WIDTH].reshape(lead + (ATT_KV_HEADS, HEAD_DIM))
    o += KV_WIDTH
    v = p[..., o:o + KV_WIDTH].reshape(lead + (ATT_KV_HEADS, HEAD_DIM))
    o += KV_WIDTH
    pool_u = p[..., o:o + POOL_WIDTH]
    o += POOL_WIDTH
    hy_u = p[..., o:o + HY_PROJ]
    return q, k, v, pool_u, hy_u


def window_attention(q, k, v, k_ctx, v_ctx, sink):
    B, S = q.shape[0], q.shape[1]
    C = k_ctx.shape[1]
    nb = S // BLOCK
    qb = q.reshape(B, nb, BLOCK, ATT_KV_HEADS, ATT_GROUP, HEAD_DIM) * (HEAD_DIM ** -0.5)

    def band(t):
        tp = jnp.pad(t, ((0, 0), (BLOCK, BLOCK), (0, 0), (0, 0)))
        tb = tp.reshape(B, nb + 2, BLOCK, ATT_KV_HEADS, HEAD_DIM)
        return jnp.concatenate([tb[:, :-2], tb[:, 1:-1], tb[:, 2:]], axis=2)

    kw, vw = band(k), band(v)
    s_loc = jnp.einsum('bnqhgd,bnkhd->bnhgqk', qb, kw).astype(F32)
    qi = jnp.arange(BLOCK)[:, None]
    ki = jnp.arange(3 * BLOCK)[None, :]
    kpos = jnp.arange(nb)[:, None, None] * BLOCK + (ki - BLOCK)[None]
    mask = (jnp.abs(ki - BLOCK - qi) <= WINDOW)[None] & (kpos >= 0) & (kpos < S)
    s_loc = jnp.where(mask[None, :, None, None], s_loc, NEG)
    s_ctx = jnp.einsum('bnqhgd,bchd->bnhgqc', qb, k_ctx).astype(F32)
    s_sink = jnp.broadcast_to(sink.astype(F32).reshape(1, 1, ATT_KV_HEADS, ATT_GROUP, 1, 1),
                              s_loc.shape[:-1] + (1,))
    p = jax.nn.softmax(jnp.concatenate([s_loc, s_ctx, s_sink], axis=-1), axis=-1).astype(v.dtype)
    o = (jnp.einsum('bnhgqk,bnkhd->bnqhgd', p[..., :3 * BLOCK], vw)
         + jnp.einsum('bnhgqc,bchd->bnqhgd', p[..., 3 * BLOCK:3 * BLOCK + C], v_ctx))
    return o.reshape(B, S, ATT_WIDTH)


def context_attention(q, k, v, sink):
    B, C = q.shape[0], q.shape[1]
    qg = q.reshape(B, C, ATT_KV_HEADS, ATT_GROUP, HEAD_DIM) * (HEAD_DIM ** -0.5)
    s = jnp.einsum('bqhgd,bkhd->bhgqk', qg, k).astype(F32)
    s_sink = jnp.broadcast_to(sink.astype(F32).reshape(1, ATT_KV_HEADS, ATT_GROUP, 1, 1),
                              s.shape[:-1] + (1,))
    p = jax.nn.softmax(jnp.concatenate([s, s_sink], axis=-1), axis=-1).astype(v.dtype)
    o = jnp.einsum('bhgqk,bkhd->bqhgd', p[..., :C], v)
    return o.reshape(B, C, ATT_WIDTH)


def pool_mixer(u, w, scale):
    B, L, _ = u.shape
    uf = u.astype(F32)
    pos = jnp.arange(L)
    outs = []
    for g, win in enumerate(POOL_WINDOWS):
        ug = uf[..., g * POOL_GROUP:(g + 1) * POOL_GROUP]
        cs = jnp.concatenate([jnp.zeros((B, 1, POOL_GROUP), F32), jnp.cumsum(ug, axis=1)], axis=1)
        lo = jnp.clip(pos - win // 2, 0, L)
        hi = jnp.clip(pos + win - win // 2, 0, L)
        mean = (cs[:, hi] - cs[:, lo]) / (hi - lo).astype(F32)[None, :, None]
        outs.append((mean - ug) @ w[g].astype(F32))
    return (jnp.concatenate(outs, axis=-1) * scale.astype(F32)).astype(u.dtype)


def hyena_filters(L, w1, b1, w2, b2, w3, b3, freq):
    m = jnp.arange(L, dtype=F32)
    t = m / max(L - 1, 1)
    w = 2.0 * math.pi * m / L
    f = jnp.linspace(1e-4, HY_BANDS - 1, HY_BANDS, dtype=F32)
    z = jnp.concatenate([t[:, None], jnp.cos(w[:, None] * f), -jnp.sin(w[:, None] * f)], axis=-1)
    fr = freq.astype(F32)
    a = jnp.sin(fr * (z @ w1.astype(F32) + b1.astype(F32)))
    a = jnp.sin(fr * (a @ w2.astype(F32) + b2.astype(F32)))
    h = a @ w3.astype(F32) + b3.astype(F32)
    max_decay = math.log(HY_TARGET) / HY_SHORT_DECAY_PCT
    min_decay = math.log(HY_TARGET) / HY_LONG_DECAY_PCT
    deltas = jnp.linspace(min_decay, max_decay, HY_WIDTH, dtype=F32)
    decay = jnp.exp(-t[:, None] * jnp.abs(deltas)[None])
    h = h.reshape(L, HY_ORDER, 2, HY_WIDTH) * decay[:, None, None, :]
    fwd, bwd = h[:, :, 0], h[:, :, 1]
    two_sided = jnp.concatenate([fwd, jnp.zeros((1, HY_ORDER, HY_WIDTH), F32), bwd[1:][::-1]], axis=0)
    return jnp.fft.rfft(two_sided, axis=0)


def hyena_mixer(u, conv_w, conv_b, kf, d_bias):
    out_dtype = u.dtype
    L = u.shape[1]
    pad = HY_SHORT // 2
    up = jnp.pad(u, ((0, 0), (pad, pad), (0, 0)))
    u = sum(up[:, j:j + L] * conv_w[j] for j in range(HY_SHORT)) + conv_b
    v, x1, x2 = jnp.split(u.astype(F32), HY_ORDER + 1, axis=-1)
    gates = (x1, x2)
    z = v
    for o in range(HY_ORDER):
        zf = jnp.fft.rfft(z, n=2 * L, axis=1)
        conv = jnp.fft.irfft(zf * kf[None, :, o], n=2 * L, axis=1)[:, :L]
        z = gates[o] * (conv + z * d_bias[o].astype(F32))
    return z.astype(out_dtype)


def swiglu(h, w1, w3, w2):
    return (jax.nn.silu(h @ w1) * (h @ w3)) @ w2


def moe_swiglu(h, router_w, w1, w3, w2):
    shp = h.shape
    t = h.reshape(-1, shp[-1])
    logits = (t @ router_w).astype(F32)
    top_v, top_i = lax.top_k(logits, TOP_K)
    wts = jax.nn.softmax(top_v, axis=-1)
    gates = jnp.sum(jax.nn.one_hot(top_i, N_EXPERTS, dtype=F32) * wts[..., None], axis=1)
    out = jnp.zeros_like(t)
    for e in range(N_EXPERTS):
        out = out + gates[:, e:e + 1].astype(t.dtype) * swiglu(t, w1[e], w3[e], w2[e])
    return out.reshape(shp)


def setup_inputs(seed: int = 0) -> dict:
    key = jax.random.key(seed)
    ks = iter(jax.random.split(key, 48))
    D = D_MODEL
    Lr = DEPTH

    def nrm(shape, s):
        return jax.random.normal(next(ks), shape, F32) * s

    return {
        'x': nrm((BATCH, SEQ, D), 1.0),
        'c': nrm((BATCH, D), 1.0),
        'ctx': nrm((BATCH, CTX_LEN, D), 1.0),
        'c_ctx': nrm((D,), 1.0),
        'w_mod': nrm((Lr, D, 6 * D), 0.5 * D ** -0.5),
        'b_mod': nrm((Lr, 6 * D), 0.02),
        'norm1_g': 1.0 + nrm((Lr, D), 0.02),
        'w_in': nrm((Lr, D, IN_WIDTH), D ** -0.5),
        'attn_sink': nrm((Lr, ATT_HEADS), 1.0),
        'pool_w': nrm((Lr, len(POOL_WINDOWS), POOL_GROUP, POOL_GROUP), POOL_GROUP ** -0.5),
        'pool_scale': 1.0 + nrm((Lr, POOL_WIDTH), 0.1),
        'hy_conv_w': nrm((Lr, HY_SHORT, HY_PROJ), HY_SHORT ** -0.5),
        'hy_conv_b': nrm((Lr, HY_PROJ), 0.02),
        'hy_f_w1': nrm((Lr, HY_EMB, HY_FILTER_HIDDEN), HY_EMB ** -0.5),
        'hy_f_b1': nrm((Lr, HY_FILTER_HIDDEN), 0.02),
        'hy_f_w2': nrm((Lr, HY_FILTER_HIDDEN, HY_FILTER_HIDDEN), HY_FILTER_HIDDEN ** -0.5),
        'hy_f_b2': nrm((Lr, HY_FILTER_HIDDEN), 0.02),
        'hy_f_w3': nrm((Lr, HY_FILTER_HIDDEN, HY_ORDER * 2 * HY_WIDTH), HY_FILTER_HIDDEN ** -0.5),
        'hy_f_b3': nrm((Lr, HY_ORDER * 2 * HY_WIDTH), 0.02),
        'hy_f_freq': 1.0 + nrm((Lr, HY_FILTER_HIDDEN), 0.1),
        'hy_bias': nrm((Lr, HY_ORDER, HY_WIDTH), 1.0),
        'g_attn': 1.0 + nrm((Lr, ATT_WIDTH), 0.02),
        'g_pool': 1.0 + nrm((Lr, POOL_WIDTH), 0.02),
        'g_hyena': 1.0 + nrm((Lr, HY_WIDTH), 0.02),
        'w_out': nrm((Lr, MIX_WIDTH, D), MIX_WIDTH ** -0.5),
        'norm2_g': 1.0 + nrm((Lr, D), 0.02),
        'ff_w1': nrm((N_DENSE, D, D_FF), D ** -0.5),
        'ff_w3': nrm((N_DENSE, D, D_FF), D ** -0.5),
        'ff_w2': nrm((N_DENSE, D_FF, D), D_FF ** -0.5),
        'router_w': nrm((N_MOE, D, N_EXPERTS), D ** -0.5),
        'moe_w1': nrm((N_MOE, N_EXPERTS, D, D_FF), D ** -0.5),
        'moe_w3': nrm((N_MOE, N_EXPERTS, D, D_FF), D ** -0.5),
        'moe_w2': nrm((N_MOE, N_EXPERTS, D_FF, D), D_FF ** -0.5),
        'final_g': 1.0 + nrm((D,), 0.02),
    }


def reference(x, c, ctx, c_ctx, w_mod, b_mod, norm1_g, w_in, attn_sink, pool_w, pool_scale,
              hy_conv_w, hy_conv_b, hy_f_w1, hy_f_b1, hy_f_w2, hy_f_b2, hy_f_w3, hy_f_b3,
              hy_f_freq, hy_bias, g_attn, g_pool, g_hyena, w_out, norm2_g,
              ff_w1, ff_w3, ff_w2, router_w, moe_w1, moe_w3, moe_w2, final_g):
    S = x.shape[1]
    D = x.shape[2]
    rope = axial_rope_tables(S)
    silu_c = jax.nn.silu(c)
    silu_cc = jax.nn.silu(c_ctx)[None]
    xc = ctx

    def hyena_branch(l, u):
        kf = hyena_filters(u.shape[1], hy_f_w1[l], hy_f_b1[l], hy_f_w2[l], hy_f_b2[l],
                           hy_f_w3[l], hy_f_b3[l], hy_f_freq[l])
        return hyena_mixer(u, hy_conv_w[l], hy_conv_b[l], kf, hy_bias[l])

    def merge(l, y_att, pool_u, hy_u):
        y = jnp.concatenate([
            rmsnorm(y_att, g_attn[l]),
            rmsnorm(pool_mixer(pool_u, pool_w[l], pool_scale[l]), g_pool[l]),
            rmsnorm(hyena_branch(l, hy_u), g_hyena[l]),
        ], axis=-1)
        return y @ w_out[l]

    def channel_mixer(l, h):
        i = l // 2
        if l % 2 == 0:
            return swiglu(h, ff_w1[i], ff_w3[i], ff_w2[i])
        return moe_swiglu(h, router_w[i], moe_w1[i], moe_w3[i], moe_w2[i])

    for l in range(DEPTH):
        last = l == DEPTH - 1
        mod = silu_c @ w_mod[l] + b_mod[l]
        sh1, sc1, g1, sh2, sc2, g2 = jnp.split(mod, 6, axis=-1)
        h = modulate(rmsnorm(x, norm1_g[l]), sh1, sc1)
        q, k, v, pool_u, hy_u = split_proj(h @ w_in[l])

        if last:
            mod_c = silu_cc @ w_mod[l][:, :2 * D] + b_mod[l][:2 * D]
            csh1, csc1 = jnp.split(mod_c, 2, axis=-1)
            hc = modulate(rmsnorm(xc, norm1_g[l]), csh1, csc1)
            kv_c = hc @ w_in[l][:, ATT_WIDTH:ATT_WIDTH + 2 * KV_WIDTH]
            lead = kv_c.shape[:-1]
            k_c = kv_c[..., :KV_WIDTH].reshape(lead + (ATT_KV_HEADS, HEAD_DIM))
            v_c = kv_c[..., KV_WIDTH:].reshape(lead + (ATT_KV_HEADS, HEAD_DIM))
        else:
            mod_c = silu_cc @ w_mod[l] + b_mod[l]
            csh1, csc1, cg1, csh2, csc2, cg2 = jnp.split(mod_c, 6, axis=-1)
            hc = modulate(rmsnorm(xc, norm1_g[l]), csh1, csc1)
            q_c, k_c, v_c, pool_c, hy_c = split_proj(hc @ w_in[l])
            yc = merge(l, context_attention(q_c, k_c, v_c, attn_sink[l]), pool_c, hy_c)
            xc_new = xc + cg1[:, None] * yc
            hc2 = modulate(rmsnorm(xc_new, norm2_g[l]), csh2, csc2)
            xc_new = xc_new + cg2[:, None] * channel_mixer(l, hc2)

        q = apply_axial_rope(q, rope)
        k = apply_axial_rope(k, rope)
        y_att = window_attention(q, k, v, k_c, v_c, attn_sink[l])
        x = x + g1[:, None] * merge(l, y_att, pool_u, hy_u)
        h2 = modulate(rmsnorm(x, norm2_g[l]), sh2, sc2)
        x = x + g2[:, None] * channel_mixer(l, h2)

        if not last:
            xc = xc_new

    return rmsnorm(x, final_g)
```

```cpp
#include <hip/hip_runtime.h>
#include <cstdio>
#include <cstdint>

#ifndef MK_PER_PHASE
#define MK_PER_PHASE 0
#endif
#ifndef PROBE_MASK
#define PROBE_MASK 0u
#endif

namespace pg8 {
#define PG8_LAS __attribute__((address_space(3)))
typedef unsigned short bf16_t;
typedef short bf16x8 __attribute__((ext_vector_type(8)));
typedef float f32x4 __attribute__((ext_vector_type(4)));
typedef unsigned u32x4 __attribute__((ext_vector_type(4)));
constexpr int BM = 256, BK = 64, HALF = 128, HTB = HALF * BK * 2, STAGE_BYTES = 8 * HTB, NXCD = 8, WGM = 8;

__host__ __device__ __forceinline__ int lds_byte(int r, int c) { const int st = (r >> 4) * 2 + (c >> 5), rr = r & 15, cc = c & 31, ob = rr * 64 + cc * 2; return st * 1024 + (ob ^ (((ob >> 9) & 1) << 5)); }
__host__ __device__ __forceinline__ void stage_rc(int b, int& R, int& C) { const int st = b / 1024, sb = b % 1024, swz = sb ^ (((sb >> 9) & 1) << 5); R = (st >> 1) * 16 + swz / 64; C = (st & 1) * 32 + (swz % 64) / 2; }
__host__ __device__ __forceinline__ int perm32(int rho) { const int n = rho >> 4, i = rho & 15; return 8 * (i >> 2) + 4 * n + (i & 3); }

struct Unit { int pm, pn, orow, ocol, kind; };
struct Gemm { const bf16_t* A; const bf16_t* Bt; int K; };

struct StaticOrder {
    int nM, nN, nwg, G, c;
    __host__ __device__ void init(int M, int N, int G_, int c_) { nM = M / BM; nN = N / BM; nwg = nM * nN; G = G_; c = c_; }
    __host__ __device__ void map(int L, int& pm, int& pn) const {
        int wgid = L; { const int q = nwg / NXCD, r = nwg % NXCD, xcd = wgid % NXCD, off = wgid / NXCD; wgid = (xcd < r ? xcd * (q + 1) : r * (q + 1) + (xcd - r) * q) + off; }
        const int nig = WGM * nN, gid = wgid / nig, fm = gid * WGM, gsz = (nM - fm) < WGM ? (nM - fm) : WGM;
        pm = fm + ((wgid % nig) % gsz); pn = (wgid % nig) / gsz;
    }
    __host__ __device__ bool next(int i, Unit& u) const {
        const long L = (long)i * G + c; if (L >= nwg) return false;
        int pm, pn; map((int)L, pm, pn); u.pm = pm; u.pn = pn; u.orow = pm * BM; u.ocol = pn * BM; u.kind = 0; return true;
    }
    __device__ __forceinline__ void a_ready(const Unit&) const {}
    __device__ __forceinline__ void done(const Unit&) const {}
};

__device__ __forceinline__ unsigned cvt_pk_bf16(float lo, float hi) { unsigned r; asm volatile("v_cvt_pk_bf16_f32 %0, %1, %2" : "=v"(r) : "v"(lo), "v"(hi)); return r; }

template <bool F8> struct pg8_frag;
template <> struct pg8_frag<false> { struct T { bf16x8 k0, k1; };
    static __device__ __forceinline__ T load(const PG8_LAS u32x4* p0, const PG8_LAS u32x4* p1) { T t; t.k0 = __builtin_bit_cast(bf16x8, *p0); t.k1 = __builtin_bit_cast(bf16x8, *p1); return t; }
    static __device__ __forceinline__ f32x4 mma(const T& b, const T& a, f32x4 c) { c = __builtin_amdgcn_mfma_f32_16x16x32_bf16(b.k0, a.k0, c, 0, 0, 0); return __builtin_amdgcn_mfma_f32_16x16x32_bf16(b.k1, a.k1, c, 0, 0, 0); } };
template <> struct pg8_frag<true> { typedef int T __attribute__((ext_vector_type(8)));
    static __device__ __forceinline__ T load(const PG8_LAS u32x4* p0, const PG8_LAS u32x4* p1) { const u32x4 a = *p0, b = *p1; return (T){(int)a.x, (int)a.y, (int)a.z, (int)a.w, (int)b.x, (int)b.y, (int)b.z, (int)b.w}; }
    static __device__ __forceinline__ f32x4 mma(const T& b, const T& a, f32x4 c) { const int one = 0x7f7f7f7f;
        asm volatile("v_mfma_scale_f32_16x16x128_f8f6f4 %0, %1, %2, %0, %3, %3 op_sel_hi:[0,0,0]" : "+v"(c) : "v"(b), "v"(a), "v"(one)); return c; } };
template <class Epi, class Sched, bool ALIGN_EPI = false, bool SP2 = false, bool F8 = false>
__device__ __forceinline__ void gemm_phase(PG8_LAS unsigned char* lds, const Gemm g, const Sched& S, const Epi& E, const int tid) {
    const int wid = __builtin_amdgcn_readfirstlane(tid >> 6), lane = tid & 63, wr = wid >> 2, wc = wid & 3, fr = lane & 15, fq = lane >> 4;
    const int K = g.K, nt = K / BK;
    unsigned voffA[2], voffB[2];
#pragma unroll
    for (int i = 0; i < 2; ++i) { int R, C; stage_rc(tid * 16 + i * 8192, R, C); const int Rb = Epi::PERM ? ((R & ~31) + perm32(R & 31)) : R;
        voffA[i] = (unsigned)(R * K + C) * 2u; voffB[i] = (unsigned)(Rb * K + C) * 2u; }
    const size_t kstep = (size_t)(BK * 2);
    const size_t hstep = (size_t)HALF * K * 2;
    const size_t tstep = 2 * hstep;
    const unsigned ldsw = (unsigned)wid * 1024u;
    const int aoff = lds_byte(wr * 64 + fr, fq * 8), boff = lds_byte(wc * 32 + fr, fq * 8);
#define PG8_SA(b, h) (((b) * 2 + (h)) * HTB)
#define PG8_SB(b, h) ((4 + (b) * 2 + (h)) * HTB)
#define PG8_STAGE(bufoff, gbase, voff) do { _Pragma("unroll") for (int _i = 0; _i < 2; ++_i) \
        __builtin_amdgcn_global_load_lds((const unsigned*)((const char*)(gbase) + (voff)[_i]), (PG8_LAS unsigned*)(lds + (bufoff) + ldsw + _i * 8192), 16, 0, 0); } while (0)
#define PG8_LDF(p) pg8_frag<F8>::load((const PG8_LAS u32x4*)(p), (const PG8_LAS u32x4*)((p) + 1024))
#define PG8_LDA(dst, b, h) do { _Pragma("unroll") for (int m = 0; m < 4; ++m) dst[m] = PG8_LDF(lds + PG8_SA(b, h) + aoff + m * 2048); } while (0)
#define PG8_LDB(dst, b, h) do { _Pragma("unroll") for (int n = 0; n < 2; ++n) dst[n] = PG8_LDF(lds + PG8_SB(b, h) + boff + n * 2048); } while (0)
#define PG8_MMA(ai, bj, At, Bt) do { __builtin_amdgcn_s_setprio(1); _Pragma("unroll") for (int m = 0; m < 4; ++m) _Pragma("unroll") for (int n = 0; n < 2; ++n) \
        acc[ai][bj][m][n] = pg8_frag<F8>::mma(Bt[n], At[m], acc[ai][bj][m][n]); __builtin_amdgcn_s_setprio(0); } while (0)
#define PG8_WAIT_V(n) asm volatile("s_waitcnt vmcnt(" #n ")" ::: "memory")
#define PG8_WAIT_L(n) asm volatile("s_waitcnt lgkmcnt(" #n ")" ::: "memory")
#define PG8_BAR __builtin_amdgcn_s_barrier()
#define PG8_SCHED __builtin_amdgcn_sched_barrier(0)
    Unit cur, nxt; int ui = 0;
    if (!S.next(0, cur)) return;
    f32x4 acc[2][2][4][2];
#pragma unroll
    for (int a = 0; a < 2; ++a)
#pragma unroll
        for (int b = 0; b < 2; ++b)
#pragma unroll
            for (int m = 0; m < 4; ++m)
#pragma unroll
                for (int n = 0; n < 2; ++n) acc[a][b][m][n] = (f32x4){0.f, 0.f, 0.f, 0.f};
    typename pg8_frag<F8>::T At[4], B0[2], B1[2];
    const char* cA = (const char*)g.A + (size_t)cur.pm * tstep; const char* cB = (const char*)g.Bt + (size_t)cur.pn * tstep;
    S.a_ready(cur);
    if constexpr (SP2) {
        PG8_STAGE(PG8_SB(0, 0), cB, voffB); PG8_STAGE(PG8_SB(0, 1), cB + hstep, voffB); PG8_STAGE(PG8_SA(0, 0), cA, voffA); PG8_STAGE(PG8_SA(0, 1), cA + hstep, voffA);
        if (wr == 1) PG8_BAR;
        PG8_WAIT_V(2); PG8_BAR;
        PG8_STAGE(PG8_SB(1, 0), cB + kstep, voffB); PG8_STAGE(PG8_SA(1, 0), cA + kstep, voffA); PG8_STAGE(PG8_SB(1, 1), cB + hstep + kstep, voffB);
        PG8_WAIT_V(6); PG8_BAR;
    } else {
        PG8_STAGE(PG8_SB(0, 0), cB, voffB); PG8_STAGE(PG8_SA(0, 0), cA, voffA); PG8_STAGE(PG8_SB(0, 1), cB + hstep, voffB); PG8_STAGE(PG8_SA(0, 1), cA + hstep, voffA);
        if (wr == 1) PG8_BAR;
        PG8_WAIT_V(4); PG8_BAR;
        PG8_STAGE(PG8_SB(1, 0), cB + kstep, voffB); PG8_STAGE(PG8_SA(1, 0), cA + kstep, voffA); PG8_STAGE(PG8_SB(1, 1), cB + hstep + kstep, voffB);
        PG8_WAIT_V(6); PG8_BAR;
    }
    for (;;) {
        const bool has_next = S.next(ui + 1, nxt);
        const char* nA = has_next ? (const char*)g.A + (size_t)nxt.pm * tstep : cA; const char* nB = has_next ? (const char*)g.Bt + (size_t)nxt.pn * tstep : cB;
        for (int t = 0; t < nt; t += 2) {
            const bool last = (t == nt - 2);
            const char* a1 = cA + (size_t)(t + 1) * kstep;
            const char* a2 = last ? nA : cA + (size_t)(t + 2) * kstep; const char* b2 = last ? nB : cB + (size_t)(t + 2) * kstep;
            const char* a3 = a2 + kstep; const char* b3 = b2 + kstep;
            if (last && has_next) S.a_ready(nxt);
            if constexpr (SP2) {
            PG8_LDB(B0, 0, 0); PG8_LDB(B1, 0, 1); PG8_SCHED; PG8_LDA(At, 0, 0); PG8_STAGE(PG8_SA(1, 1), a1 + hstep, voffA);
            PG8_WAIT_V(8); PG8_WAIT_L(0); PG8_BAR; PG8_MMA(0, 0, At, B0); PG8_MMA(0, 1, At, B1); PG8_BAR; PG8_SCHED;
            PG8_LDA(At, 0, 1); PG8_STAGE(PG8_SB(0, 0), b2, voffB); PG8_STAGE(PG8_SB(0, 1), b2 + hstep, voffB); PG8_STAGE(PG8_SA(0, 0), a2, voffA);
            PG8_WAIT_V(8); PG8_WAIT_L(0); PG8_BAR; PG8_MMA(1, 0, At, B0); PG8_MMA(1, 1, At, B1); PG8_BAR; PG8_SCHED;
            PG8_LDB(B0, 1, 0); PG8_LDB(B1, 1, 1); PG8_SCHED; PG8_LDA(At, 1, 0); PG8_STAGE(PG8_SA(0, 1), a2 + hstep, voffA);
            PG8_WAIT_V(8); PG8_WAIT_L(0); PG8_BAR; PG8_MMA(0, 0, At, B0); PG8_MMA(0, 1, At, B1); PG8_BAR; PG8_SCHED;
            PG8_LDA(At, 1, 1); PG8_STAGE(PG8_SB(1, 0), b3, voffB); PG8_STAGE(PG8_SB(1, 1), b3 + hstep, voffB); PG8_STAGE(PG8_SA(1, 0), a3, voffA);
            PG8_WAIT_V(8); PG8_WAIT_L(0); PG8_BAR; PG8_MMA(1, 0, At, B0); PG8_MMA(1, 1, At, B1); PG8_BAR; PG8_SCHED;
            } else {
            PG8_LDB(B0, 0, 0); PG8_SCHED; PG8_LDA(At, 0, 0); PG8_STAGE(PG8_SA(1, 1), a1 + hstep, voffA);
            PG8_WAIT_L(8); PG8_BAR; PG8_WAIT_L(0); PG8_MMA(0, 0, At, B0); PG8_BAR; PG8_SCHED;
            PG8_LDB(B1, 0, 1); PG8_STAGE(PG8_SB(0, 0), b2, voffB);
            PG8_BAR; PG8_WAIT_L(0); PG8_MMA(0, 1, At, B1); PG8_BAR;
            PG8_LDA(At, 0, 1); PG8_STAGE(PG8_SA(0, 0), a2, voffA);
            PG8_BAR; PG8_WAIT_L(0); PG8_MMA(1, 0, At, B0); PG8_BAR; PG8_SCHED;
            PG8_STAGE(PG8_SB(0, 1), b2 + hstep, voffB);
            PG8_WAIT_V(6); PG8_BAR; PG8_MMA(1, 1, At, B1); PG8_BAR;
            PG8_LDB(B0, 1, 0); PG8_SCHED; PG8_LDA(At, 1, 0); PG8_STAGE(PG8_SA(0, 1), a2 + hstep, voffA);
            PG8_WAIT_L(8); PG8_BAR; PG8_WAIT_L(0); PG8_MMA(0, 0, At, B0); PG8_BAR; PG8_SCHED;
            PG8_LDB(B1, 1, 1); PG8_STAGE(PG8_SB(1, 0), b3, voffB);
            PG8_BAR; PG8_WAIT_L(0); PG8_MMA(0, 1, At, B1); PG8_BAR;
            PG8_LDA(At, 1, 1); PG8_STAGE(PG8_SA(1, 0), a3, voffA);
            PG8_BAR; PG8_WAIT_L(0); PG8_MMA(1, 0, At, B0); PG8_BAR; PG8_SCHED;
            PG8_STAGE(PG8_SB(1, 1), b3 + hstep, voffB);
            PG8_WAIT_V(6); PG8_BAR; PG8_MMA(1, 1, At, B1); PG8_BAR;
            }
        }
        if constexpr (ALIGN_EPI) { if (wr == 0) PG8_BAR; }
        if constexpr (F8) asm volatile("s_nop 15\n\ts_nop 15" ::: "memory");
        E(acc, cur, wr, wc, fr, fq); S.done(cur);
        if (!has_next) break;
#pragma unroll
        for (int a = 0; a < 2; ++a)
#pragma unroll
            for (int b = 0; b < 2; ++b)
#pragma unroll
                for (int m = 0; m < 4; ++m)
#pragma unroll
                    for (int n = 0; n < 2; ++n) acc[a][b][m][n] = (f32x4){0.f, 0.f, 0.f, 0.f};
        cur = nxt; cA = nA; cB = nB; ++ui;
        if constexpr (ALIGN_EPI) { if (wr == 1) PG8_BAR; }
    }
    PG8_WAIT_V(0);
    if constexpr (!ALIGN_EPI) { if (wr == 0) PG8_BAR; }
    PG8_BAR;
#undef PG8_SA
#undef PG8_SB
#undef PG8_STAGE
#undef PG8_LDA
#undef PG8_LDB
#undef PG8_MMA
#undef PG8_WAIT_V
#undef PG8_WAIT_L
#undef PG8_BAR
#undef PG8_SCHED
}
}

typedef unsigned short bf16;
typedef float f32x4 __attribute__((ext_vector_type(4)));
typedef float f32x2 __attribute__((ext_vector_type(2)));
typedef unsigned v4u __attribute__((ext_vector_type(4)));
typedef unsigned v2u __attribute__((ext_vector_type(2)));
#define LAS __attribute__((address_space(3)))
#define GAS __attribute__((address_space(1)))

constexpr int NWAVES = 8, NTHR = 512;
constexpr int DM = 2048, NBATCH = 4, SEQ = 8192, NLAT = NBATCH * SEQ, CTXL = 256, NCTX = NBATCH * CTXL, MTOT = NLAT + NCTX;
constexpr int ATTW = 1024, KVW = 256, POOLW = 512, HYW = 512, HYP = 1536, INW = 3584, QKVP = 2048;
constexpr int DFF = 5632, NEXP = 8;
constexpr int MODW = 6 * DM;
constexpr float EPS = 1e-6f;
constexpr int MOE_CAP_PANELS = 264;
constexpr int MOE_MAX_ROWS = 2 * NLAT + NEXP * 256;

constexpr size_t MiB = 1u << 20;
constexpr size_t WS_CTL = 0;
constexpr size_t CTL_ZERO_BYTES = 1 * MiB;
constexpr size_t WS_MOD = 1 * MiB;
constexpr size_t WS_ROPE = 2 * MiB;
constexpr size_t WS_A2 = 3 * MiB;
constexpr size_t WS_ROUTE = 8 * MiB;
constexpr size_t WS_TW = 9 * MiB;
constexpr size_t WS_DFT = 20 * MiB;
constexpr size_t WS_A2B = 18 * MiB;
constexpr size_t WS_POOLWT = 9 * MiB + 512 * 1024;
constexpr size_t WS_XC = 10 * MiB;
constexpr size_t WS_UNI = 32 * MiB;
constexpr size_t UNI_BYTES = (size_t)(INW + MTOT + INW) * DM * 2;
constexpr size_t WS_WOUT = WS_UNI + UNI_BYTES;
constexpr size_t WS_FF13 = WS_WOUT + 16 * MiB;
constexpr size_t WS_FF2 = WS_FF13 + 22 * MiB;
constexpr size_t WS_MOE13 = WS_FF2 + 11 * MiB;
constexpr size_t WS_MOE2 = WS_MOE13 + 176 * MiB;
constexpr size_t WS_R = WS_MOE2 + 88 * MiB;
constexpr size_t WS_PROJ = WS_R;
constexpr size_t WS_HYT = WS_PROJ + (size_t)MTOT * QKVP * 2;
constexpr size_t WS_ATT = WS_HYT + (size_t)HYP * MTOT * 2;
constexpr size_t WS_POOL = WS_ATT + (size_t)MTOT * ATTW * 4;
constexpr size_t WS_ZT = WS_POOL + (size_t)MTOT * POOLW * 4;
constexpr size_t WS_KF = WS_ZT + (size_t)HYW * MTOT * 4;
constexpr size_t WS_HS = WS_KF + (size_t)256 * 2 * 16384 * 8;
constexpr size_t WS_R_MIX_END = WS_HS + (size_t)256 * 6 * 8192 * 4;
constexpr size_t WS_HID = WS_R;
constexpr size_t WS_AG = WS_HID + (size_t)MTOT * DFF * 2;
constexpr size_t WS_R_FFN_END = WS_AG + (size_t)MOE_MAX_ROWS * DM * 2;
constexpr size_t WS_YE = (WS_R_FFN_END > WS_R_MIX_END ? WS_R_FFN_END : WS_R_MIX_END);
constexpr size_t WS_X16 = WS_YE + (size_t)MOE_MAX_ROWS * DM * 2;
constexpr size_t WS_END = WS_X16 + (size_t)MTOT * DM * 2;

constexpr int CW_BAR = 4096;
constexpr int LDS_BYTES = 147456;
constexpr int LDSCTL_OFF = LDS_BYTES - 256;
constexpr int LDS_USABLE = LDSCTL_OFF;

__device__ __forceinline__ float bf2f(bf16 b) { return __uint_as_float(((unsigned)b) << 16); }
__device__ __forceinline__ unsigned f2bf(float f) { unsigned u = __float_as_uint(f); return (u + 0x7fffu + ((u >> 16) & 1u)) >> 16; }
__device__ __forceinline__ unsigned pk2(float lo, float hi) { return f2bf(lo) | (f2bf(hi) << 16); }
__device__ __forceinline__ float wave_sum(float v) {
#pragma unroll
    for (int o = 1; o < 64; o <<= 1) v += __shfl_xor(v, o);
    return v;
}
__device__ __forceinline__ float wave_max(float v) {
#pragma unroll
    for (int o = 1; o < 64; o <<= 1) v = fmaxf(v, __shfl_xor(v, o));
    return v;
}
__device__ __forceinline__ float silu_f(float x) { return x / (1.0f + __expf(-x)); }
#define LDS_WAIT() asm volatile("s_waitcnt lgkmcnt(0)" ::: "memory")

#define XB_TMO      128
#define XB_XCNT(j)  (256  + 64 * (j))
#define XB_XSUB(j)  (1280 + 64 * (j))
#define XB_XGEN(j)  (2304 + 64 * (j))
#define XB_TOP      3328
#define XB_TOPGEN   3392
#define XCD_BAR_WORDS 3456
#define XB_SPIN_CAP (1u << 22)

__device__ __forceinline__ unsigned xb_ld(unsigned* p)              { return __hip_atomic_load(p, __ATOMIC_RELAXED, __HIP_MEMORY_SCOPE_AGENT); }
__device__ __forceinline__ unsigned xb_add(unsigned* p, unsigned v) { return __hip_atomic_fetch_add(p, v, __ATOMIC_RELAXED, __HIP_MEMORY_SCOPE_AGENT); }
__device__ __forceinline__ unsigned xb_xcc_id() { return (unsigned)__builtin_amdgcn_s_getreg((3 << 11) | 20) & 0xFu; }
#define XB_SPIN(cond, bar) do { unsigned _sp = 0; while (cond) { __builtin_amdgcn_s_sleep(1); \
    if ((++_sp & 255u) == 0u) { if (xb_ld(&(bar)[XB_TMO])) break; if (_sp > XB_SPIN_CAP) { atomicAdd(&(bar)[XB_TMO], 1u); break; } } } } while (0)

struct XcdBarrier { unsigned* bar; unsigned x; volatile LAS unsigned* st; };

__device__ __forceinline__ XcdBarrier xcd_barrier_post(unsigned* bar, volatile LAS unsigned* st) {
    XcdBarrier b; b.bar = bar; b.x = xb_xcc_id(); b.st = st;
    if (threadIdx.x == 0) (void)xb_add(&bar[XB_XCNT(b.x)], 1u);
    return b;
}
__device__ __forceinline__ void xcd_barrier_complete(unsigned* bar, unsigned x, unsigned& nloc, unsigned& nx) {
    const unsigned G = gridDim.x * gridDim.y * gridDim.z;
    unsigned sum, cnt, mine, sp = 0u;
    for (;;) {
        sum = 0u; cnt = 0u; mine = 0u;
#pragma unroll
        for (unsigned j = 0; j < 16; ++j) { const unsigned c = xb_ld(&bar[XB_XCNT(j)]); sum += c; cnt += (c > 0u) ? 1u : 0u; mine = (j == x) ? c : mine; }
        if (sum == G) break;
        __builtin_amdgcn_s_sleep(1);
        if ((++sp & 255u) == 0u) { if (xb_ld(&bar[XB_TMO])) break; if (sp > XB_SPIN_CAP) { atomicAdd(&bar[XB_TMO], 1u); break; } }
    }
    nloc = mine > 0u ? mine : 1u; nx = cnt > 0u ? cnt : 1u;
}
__device__ __forceinline__ void xcd_barrier(const XcdBarrier& b) {
    asm volatile("s_waitcnt vmcnt(0)" ::: "memory");
    __syncthreads();
    if (threadIdx.x == 0) {
        unsigned* bar = b.bar;
        __builtin_amdgcn_s_waitcnt(0);
        unsigned nloc = b.st[0], nx = b.st[1];
        if (nloc == 0u) { xcd_barrier_complete(bar, b.x, nloc, nx); b.st[0] = nloc; b.st[1] = nx; }
        const unsigned old = xb_add(&bar[XB_XSUB(b.x)], 1u);
        const unsigned gen = old / nloc;
        if (old + 1u == (gen + 1u) * nloc) {
            __builtin_amdgcn_fence(__ATOMIC_RELEASE, "agent");
            asm volatile("s_waitcnt vmcnt(0)" ::: "memory");
            const unsigned og = xb_add(&bar[XB_TOP], 1u);
            const unsigned tg = og / nx;
            if (og + 1u == (tg + 1u) * nx) xb_add(&bar[XB_TOPGEN], 1u);
            else XB_SPIN(xb_ld(&bar[XB_TOPGEN]) == tg, bar);
            __builtin_amdgcn_fence(__ATOMIC_ACQUIRE, "agent");
            xb_add(&bar[XB_XGEN(b.x)], 1u);
            asm volatile("s_waitcnt vmcnt(0)" ::: "memory");
        } else {
            XB_SPIN(xb_ld(&bar[XB_XGEN(b.x)]) == gen, bar);
            __builtin_amdgcn_fence(__ATOMIC_ACQUIRE, "agent");
            asm volatile("s_waitcnt vmcnt(0)" ::: "memory");
        }
    }
    __syncthreads();
}

struct Args { const float* in[34]; float* out; unsigned char* ws; int ph_lo, ph_hi; };
enum { IN_X = 0, IN_C, IN_CTX, IN_CCTX, IN_WMOD, IN_BMOD, IN_N1G, IN_WIN, IN_SINK, IN_POOLW, IN_POOLS, IN_HCW, IN_HCB, IN_FW1, IN_FB1, IN_FW2, IN_FB2, IN_FW3, IN_FB3, IN_FFREQ,
       IN_HBIAS, IN_GATT, IN_GPOOL, IN_GHY, IN_WOUT, IN_N2G, IN_FF1, IN_FF3, IN_FF2, IN_ROUTER, IN_MOE1, IN_MOE3, IN_MOE2, IN_FINALG };

struct Frame {
    LAS unsigned char* lds; unsigned char* ldsg;
    int tid, lane, wave, G, bid;
    const __attribute__((address_space(4))) unsigned long long* in; float* out; unsigned char* ws;
};
#define FIN(k) ((const float*)(const __attribute__((address_space(1))) float*)F.in[k])
#define F_mod    ((float*)(F.ws + WS_MOD))
#define F_ropec  ((float*)(F.ws + WS_ROPE))
#define F_ropes  ((float*)(F.ws + WS_ROPE) + 128 * 32)
#define F_a2     ((float*)(F.ws + WS_A2))
#define F_a2c    ((float*)(F.ws + WS_A2) + 2 * 8192 * 64)
#define F_top_e  ((int*)(F.ws + WS_ROUTE))
#define F_gatew  ((float*)(F.ws + WS_ROUTE + 256 * 1024))
#define F_tokrow ((int*)(F.ws + WS_ROUTE + 512 * 1024))
#define F_grpcnt ((int*)(F.ws + WS_ROUTE + 768 * 1024))
#define F_pstart ((int*)(F.ws + WS_ROUTE + 768 * 1024) + 2048)
#define F_xc     ((float*)(F.ws + WS_XC))
#define F_x16    ((bf16*)(F.ws + WS_X16))
#define F_uni    ((bf16*)(F.ws + WS_UNI))
#define F_woutT  ((bf16*)(F.ws + WS_WOUT))
#define F_ff13T  ((bf16*)(F.ws + WS_FF13))
#define F_ff2T   ((bf16*)(F.ws + WS_FF2))
#define F_moe13T ((bf16*)(F.ws + WS_MOE13))
#define F_moe2T  ((bf16*)(F.ws + WS_MOE2))
#define F_proj   ((bf16*)(F.ws + WS_PROJ))
#define F_hyT    ((bf16*)(F.ws + WS_HYT))
#define F_att    ((float*)(F.ws + WS_ATT))
#define F_pool   ((float*)(F.ws + WS_POOL))
#define F_zT     ((float*)(F.ws + WS_ZT))
#define F_hid    ((bf16*)(F.ws + WS_HID))
#define F_ag     ((bf16*)(F.ws + WS_AG))
#define F_ye     ((bf16*)(F.ws + WS_YE))
__device__ __forceinline__ bf16* uni_winT(const Frame& F, int l) { return F_uni + (l == 0 ? (size_t)0 : (size_t)(INW + MTOT) * DM); }
__device__ __forceinline__ bf16* uni_h(const Frame& F) { return F_uni + (size_t)INW * DM; }
__device__ __forceinline__ const float* xsrc_row(const Frame& F, int layer, int row) {
    if (row < NLAT) return (layer == 0 ? FIN(IN_X) : (const float*)F.out) + (size_t)row * DM;
    return (layer == 0 ? FIN(IN_CTX) : (const float*)F_xc) + (size_t)(row - NLAT) * DM;
}
__device__ __forceinline__ float* xw_row(const Frame& F, int row) { return row < NLAT ? F.out + (size_t)row * DM : F_xc + (size_t)(row - NLAT) * DM; }
__device__ __forceinline__ int mod_idx(int row) { return row < NLAT ? (row >> 13) : 4; }

__device__ __forceinline__ int dst_row_of(int kind, int n) {
    if (kind == 0) return n;
    if (kind == 1) {
        if (n >= 1280) return n;
        const int d = n & 127, hf = d >> 6, s = (d >> 5) & 1, i = d & 31, g = hf * 8 + (i >> 2), j = i & 3;
        return (n & ~127) + 8 * g + 4 * s + j;
    }
    if (kind == 2) return (n >> 7) * 256 + (n & 127);
    return (n >> 7) * 256 + 128 + (n & 127);
}
#define PB (F.G > 1 ? (F.G >> 1) : 1)
struct WItem { const float* W; bf16* WT; int K, N, kind, k0, n0, f8; };
__device__ __forceinline__ bool witem_decode(const Frame& F, int it, WItem& w) {
    constexpr int I_IN = (DM / 64) * (INW / 64), I_OUT = (DM / 64) * (DM / 64), I_13 = (DM / 64) * (DFF / 64), I_2 = (DFF / 64) * (DM / 64);
    constexpr int NIT = 2 * I_IN + 2 * I_OUT + 2 * I_13 + I_2 + NEXP * (2 * I_13 + I_2);
    if (it >= NIT) return false;
    int r = it; w.f8 = 0;
    if (r < 2 * I_IN) { const int l = r / I_IN; r %= I_IN; w.W = FIN(IN_WIN) + (size_t)l * DM * INW; w.K = DM; w.N = INW; w.WT = uni_winT(F, l); w.kind = 1; }
    else if ((r -= 2 * I_IN) < 2 * I_OUT) { const int l = r / I_OUT; r %= I_OUT; w.W = FIN(IN_WOUT) + (size_t)l * DM * DM; w.K = DM; w.N = DM; w.WT = F_woutT + (size_t)l * DM * DM; w.kind = 0; }
    else if ((r -= 2 * I_OUT) < I_13) { w.W = FIN(IN_FF1); w.K = DM; w.N = DFF; w.WT = F_ff13T; w.kind = 2; w.f8 = 1; }
    else if ((r -= I_13) < I_13) { w.W = FIN(IN_FF3); w.K = DM; w.N = DFF; w.WT = F_ff13T; w.kind = 3; w.f8 = 1; }
    else if ((r -= I_13) < I_2) { w.W = FIN(IN_FF2); w.K = DFF; w.N = DM; w.WT = F_ff2T; w.kind = 0; w.f8 = 1; }
    else { r -= I_2; const int e = r / (2 * I_13 + I_2); r -= e * (2 * I_13 + I_2);
        if (r < I_13) { w.W = FIN(IN_MOE1) + (size_t)e * DM * DFF; w.K = DM; w.N = DFF; w.WT = (bf16*)((unsigned char*)F_moe13T + (size_t)e * 2 * DFF * DM); w.kind = 2; w.f8 = 1; }
        else if ((r -= I_13) < I_13) { w.W = FIN(IN_MOE3) + (size_t)e * DM * DFF; w.K = DM; w.N = DFF; w.WT = (bf16*)((unsigned char*)F_moe13T + (size_t)e * 2 * DFF * DM); w.kind = 3; w.f8 = 1; }
        else { r -= I_13; w.W = FIN(IN_MOE2) + (size_t)e * DFF * DM; w.K = DFF; w.N = DM; w.WT = (bf16*)((unsigned char*)F_moe2T + (size_t)e * DM * DFF); w.kind = 0; w.f8 = 1; } }
    const int nblk = w.N / 64; w.k0 = 64 * (r / nblk); w.n0 = 64 * (r % nblk); return true;
}
#define WLOAD(R, WI_) do { const float* _p = (WI_).W + (size_t)((WI_).k0 + (lane >> 4)) * (WI_).N + (WI_).n0 + 4 * (lane & 15); \
    _Pragma("unroll") for (int _i = 0; _i < 16; ++_i) R[_i] = *(const f32x4*)(_p + (size_t)(4 * _i) * (WI_).N); } while (0)
#define WSTORE(R, WI_) do { \
    _Pragma("unroll") for (int _i = 0; _i < 16; ++_i) { LAS float* _d = scr + (4 * _i + (lane >> 4)) * 65 + 4 * (lane & 15); _d[0] = R[_i].x; _d[1] = R[_i].y; _d[2] = R[_i].z; _d[3] = R[_i].w; } \
    LDS_WAIT(); asm volatile("" ::: "memory"); \
    _Pragma("unroll") for (int _j = 0; _j < 8; ++_j) { const int _n = (lane >> 3) + 8 * _j; const LAS float* _s = scr + (8 * (lane & 7)) * 65 + _n; \
        if ((WI_).f8) { int _p0 = 0, _p1 = 0; _p0 = __builtin_amdgcn_cvt_pk_fp8_f32(_s[0 * 65] * 64.f, _s[1 * 65] * 64.f, _p0, false); _p0 = __builtin_amdgcn_cvt_pk_fp8_f32(_s[2 * 65] * 64.f, _s[3 * 65] * 64.f, _p0, true); \
            _p1 = __builtin_amdgcn_cvt_pk_fp8_f32(_s[4 * 65] * 64.f, _s[5 * 65] * 64.f, _p1, false); _p1 = __builtin_amdgcn_cvt_pk_fp8_f32(_s[6 * 65] * 64.f, _s[7 * 65] * 64.f, _p1, true); \
            *(v2u*)((unsigned char*)(WI_).WT + (size_t)dst_row_of((WI_).kind, (WI_).n0 + _n) * (WI_).K + (WI_).k0 + 8 * (lane & 7)) = (v2u){(unsigned)_p0, (unsigned)_p1}; } \
        else { v4u _o; _o.x = pk2(_s[0 * 65], _s[1 * 65]); _o.y = pk2(_s[2 * 65], _s[3 * 65]); _o.z = pk2(_s[4 * 65], _s[5 * 65]); _o.w = pk2(_s[6 * 65], _s[7 * 65]); \
        *(v4u*)((WI_).WT + (size_t)dst_row_of((WI_).kind, (WI_).n0 + _n) * (WI_).K + (WI_).k0 + 8 * (lane & 7)) = _o; } } \
    LDS_WAIT(); asm volatile("" ::: "memory"); } while (0)
__device__ __forceinline__ void p0_weights(Frame& F) {
    LAS float* scr = (LAS float*)(F.lds + F.wave * 16640);
    constexpr int I_IN = (DM / 64) * (INW / 64), I_OUT = (DM / 64) * (DM / 64), I_13 = (DM / 64) * (DFF / 64), I_2 = (DFF / 64) * (DM / 64);
    constexpr int NIT = 2 * I_IN + 2 * I_OUT + 2 * I_13 + I_2 + NEXP * (2 * I_13 + I_2), SPLIT = (NIT / 8) * 3;
    const bool late = F.bid < PB; const int lane = F.lane, nb = late ? PB : F.G - PB, NGW = nb * NWAVES, gw = (late ? F.bid : F.bid - PB) * NWAVES + F.wave;
    const int lim = (late && F.G > PB) ? SPLIT : NIT;
    f32x4 ra[16], rb[16]; WItem wa, wb;
    __syncthreads();
    int it = (late ? 0 : SPLIT) + gw; bool va = it < lim && witem_decode(F, it, wa), vb;
    if (va) WLOAD(ra, wa);
    while (va) {
        it += NGW; vb = it < lim && witem_decode(F, it, wb); if (vb) WLOAD(rb, wb);
        WSTORE(ra, wa);
        if (!vb) break;
        it += NGW; va = it < lim && witem_decode(F, it, wa); if (va) WLOAD(ra, wa);
        WSTORE(rb, wb);
    }
    __syncthreads();
}
#undef WLOAD
#undef WSTORE
__device__ __forceinline__ void p0_mod(Frame& F) {
    __syncthreads();
    {
        float* sc = (float*)F.ldsg;
        float* red = sc + 5 * DM;
        for (int i = F.tid; i < 5 * DM; i += NTHR) { const int v = i / DM, k = i % DM; const float x = v < 4 ? FIN(IN_C)[v * DM + k] : FIN(IN_CCTX)[k]; sc[i] = silu_f(x); }
        __syncthreads();
        for (int it = F.bid; it < 2 * (MODW / 64); it += PB) {
            const int l = it / (MODW / 64), n0 = (it % (MODW / 64)) * 64;
            const float* W = FIN(IN_WMOD) + (size_t)l * DM * MODW + n0 + F.lane;
            float a0 = 0.f, a1 = 0.f, a2 = 0.f, a3 = 0.f, a4 = 0.f;
            const int kb = F.wave * 256;
#pragma unroll 8
            for (int k = 0; k < 256; ++k) { const float w = W[(size_t)(kb + k) * MODW];
                a0 += sc[0 * DM + kb + k] * w; a1 += sc[1 * DM + kb + k] * w; a2 += sc[2 * DM + kb + k] * w; a3 += sc[3 * DM + kb + k] * w; a4 += sc[4 * DM + kb + k] * w; }
            red[(F.wave * 5 + 0) * 64 + F.lane] = a0; red[(F.wave * 5 + 1) * 64 + F.lane] = a1; red[(F.wave * 5 + 2) * 64 + F.lane] = a2; red[(F.wave * 5 + 3) * 64 + F.lane] = a3; red[(F.wave * 5 + 4) * 64 + F.lane] = a4;
            __syncthreads();
            if (F.tid < 320) { const int v = F.tid / 64, ln = F.tid % 64; float s = 0.f;
#pragma unroll
                for (int w = 0; w < 8; ++w) s += red[(w * 5 + v) * 64 + ln];
                F_mod[((size_t)l * 5 + v) * MODW + n0 + ln] = s + FIN(IN_BMOD)[l * MODW + n0 + ln]; }
            __syncthreads();
        }
    }
}
__device__ __forceinline__ void fill_dft_table(Frame& F);
__device__ __forceinline__ void p0_tables(Frame& F) {
    __syncthreads();
    for (int i = F.bid * NTHR + F.tid; i < 2 * 4 * 128 * 128; i += PB * NTHR) { const int lg = i >> 14, n = (i >> 7) & 127, k = i & 127; ((bf16*)(F.ws + WS_POOLWT))[i] = (bf16)f2bf(FIN(IN_POOLW)[(size_t)lg * 16384 + k * 128 + n]); }
    fill_dft_table(F);
    for (int i = F.bid * NTHR + F.tid; i < 128 * 32; i += PB * NTHR) {
        const int pos = i >> 5, fi = i & 31; const double inv = pow(10000.0, -(double)fi / 32.0), ang = (double)pos * inv;
        F_ropec[i] = (float)cos(ang); F_ropes[i] = (float)sin(ang);
    }
    for (int i = F.bid * NTHR + F.tid; i < 16384; i += PB * NTHR) { const double ang = 6.283185307179586476925 * (double)i / 16384.0; ((f32x2*)(F.ws + WS_TW))[i] = (f32x2){(float)cos(ang), -(float)sin(ang)}; }
    {
        float* zl = (float*)F.ldsg;
        float* a1l = zl + 8 * 40;
        constexpr int NITEM = (8192 + 8192 + 256) / 8;
        for (int it = F.bid; it < NITEM; it += PB) {
            int set, m0; if (it < 1024) { set = 0; m0 = it * 8; } else if (it < 2048) { set = 1; m0 = (it - 1024) * 8; } else { set = 2; m0 = (it - 2048) * 8; }
            const int l = set == 1 ? 1 : 0, L = set == 2 ? 256 : 8192;
            __syncthreads();
            if (F.tid < 8 * 33) { const int mi = F.tid / 33, k = F.tid % 33, m = m0 + mi; float v;
                if (k == 0) v = (float)m / (float)(L - 1);
                else { const int fi = (k - 1) & 15; const double f = 1e-4 + (double)fi * ((15.0 - 1e-4) / 15.0), w = 6.283185307179586476925 * (double)m / (double)L;
                    v = k <= 16 ? (float)cos(w * f) : -(float)sin(w * f); }
                zl[mi * 40 + k] = v; }
            __syncthreads();
            const int mi = F.tid >> 6, j = F.tid & 63;
            { const float* w1 = FIN(IN_FW1) + l * 33 * 64; float s = FIN(IN_FB1)[l * 64 + j];
#pragma unroll
              for (int k = 0; k < 33; ++k) s += zl[mi * 40 + k] * w1[k * 64 + j];
              a1l[mi * 64 + j] = sinf(FIN(IN_FFREQ)[l * 64 + j] * s); }
            __syncthreads();
            { const float* w2 = FIN(IN_FW2) + l * 64 * 64; float s = FIN(IN_FB2)[l * 64 + j];
#pragma unroll 8
              for (int k = 0; k < 64; ++k) s += a1l[mi * 64 + k] * w2[k * 64 + j];
              float* dst = set == 2 ? F_a2c : F_a2 + (size_t)set * 8192 * 64;
              const float av = sinf(FIN(IN_FFREQ)[l * 64 + j] * s); dst[(size_t)j * L + (m0 + mi)] = av;
              if (set < 2) ((bf16*)(F.ws + WS_A2B))[((size_t)set * 8192 + (m0 + mi)) * 64 + j] = (bf16)f2bf(av); }
        }
    }
}

template <int WHICH, bool ROUTE>
__device__ __forceinline__ void norm_phase(Frame& F, int layer, int nrows) {
    const float* gvec = FIN(WHICH == 0 ? IN_N1G : IN_N2G) + layer * DM;
    bf16* hbuf = uni_h(F);
    float* rwT = (float*)F.ldsg;
    LAS int* cnt = (LAS int*)(F.lds + 65536);
    if (ROUTE) { __syncthreads(); const float* rw = FIN(IN_ROUTER); for (int i = F.tid; i < DM * 8; i += NTHR) rwT[(i & 7) * DM + (i >> 3)] = rw[i]; __syncthreads(); }
    const int ngroups = ROUTE ? nrows / 128 : 1;
    for (int g = ROUTE ? F.bid : 0; g < ngroups; g += ROUTE ? F.G : 1) {
        if (ROUTE) { __syncthreads(); if (F.tid < 8) cnt[F.tid] = 0; __syncthreads(); }
        int rowb, nr;
        if (ROUTE) { rowb = g * 128 + F.wave * 16; nr = 16; }
        else { const int NW = F.G * NWAVES, gw = F.bid * NWAVES + F.wave, q = nrows / NW, rem = nrows - q * NW; rowb = gw * q + (gw < rem ? gw : rem); nr = q + (gw < rem ? 1 : 0); }
        int cur = mod_idx(rowb);
        f32x4 ca[8], cb[8];
#define NCOL(k) (512 * ((k) >> 1) + 8 * F.lane + 4 * ((k) & 1))
#define NORM_LOADMOD(MI_) do { const float* mv = F_mod + ((size_t)layer * 5 + (MI_)) * MODW + (WHICH == 0 ? 0 : 3 * DM);     \
        _Pragma("unroll") for (int k = 0; k < 8; ++k) { const int c = NCOL(k); ca[k] = *(const f32x4*)(gvec + c) * (1.0f + *(const f32x4*)(mv + DM + c)); cb[k] = *(const f32x4*)(mv + c); } } while (0)
        NORM_LOADMOD(cur);
        f32x4 nx[8];
        const bool in32 = WHICH == 0 && layer == 0;
#define NORM_LOADROW(R_) do { if (in32) { const float* xr = xsrc_row(F, 0, (R_)); _Pragma("unroll") for (int k = 0; k < 8; ++k) nx[k] = *(const f32x4*)(xr + NCOL(k)); } \
        else { const bf16* xr = F_x16 + (size_t)(R_) * DM; _Pragma("unroll") for (int j = 0; j < 4; ++j) { const v4u p = *(const v4u*)(xr + 512 * j + 8 * F.lane); \
            nx[2 * j] = (f32x4){__uint_as_float(p.x << 16), __uint_as_float(p.x & 0xffff0000u), __uint_as_float(p.y << 16), __uint_as_float(p.y & 0xffff0000u)}; \
            nx[2 * j + 1] = (f32x4){__uint_as_float(p.z << 16), __uint_as_float(p.z & 0xffff0000u), __uint_as_float(p.w << 16), __uint_as_float(p.w & 0xffff0000u)}; } } } while (0)
        if (nr > 0) NORM_LOADROW(rowb);
#pragma unroll 1
        for (int r = 0; r < nr; ++r) {
            const int row = rowb + r;
            if (!ROUTE) { const int mi = mod_idx(row); if (mi != cur) { cur = mi; NORM_LOADMOD(cur); } }
            f32x4 v[8]; float ss = 0.f;
#pragma unroll
            for (int j = 0; j < 8; ++j) { v[j] = nx[j]; ss += (v[j].x * v[j].x + v[j].y * v[j].y) + (v[j].z * v[j].z + v[j].w * v[j].w); }
            if (r + 1 < nr) NORM_LOADROW(row + 1);
            const float rs = rsqrtf(wave_sum(ss) * (1.0f / DM) + EPS);
#pragma unroll
            for (int j = 0; j < 4; ++j) { const int c = 512 * j + 8 * F.lane;
                const f32x4 y0 = v[2 * j] * rs * ca[2 * j] + cb[2 * j], y1 = v[2 * j + 1] * rs * ca[2 * j + 1] + cb[2 * j + 1]; v[2 * j] = y0; v[2 * j + 1] = y1;
                if (WHICH == 1) { int p0 = 0, p1 = 0; p0 = __builtin_amdgcn_cvt_pk_fp8_f32(y0.x, y0.y, p0, false); p0 = __builtin_amdgcn_cvt_pk_fp8_f32(y0.z, y0.w, p0, true);
                    p1 = __builtin_amdgcn_cvt_pk_fp8_f32(y1.x, y1.y, p1, false); p1 = __builtin_amdgcn_cvt_pk_fp8_f32(y1.z, y1.w, p1, true);
                    *(v2u*)((unsigned char*)hbuf + (size_t)row * DM + c) = (v2u){(unsigned)p0, (unsigned)p1}; }
                else { v4u o; o.x = pk2(y0.x, y0.y); o.y = pk2(y0.z, y0.w); o.z = pk2(y1.x, y1.y); o.w = pk2(y1.z, y1.w);
                *(v4u*)(hbuf + (size_t)row * DM + c) = o; } }
            if (ROUTE) {
                float v0 = -3.0e38f, v1 = -3.0e38f; int i0 = 0, i1 = 0;
#pragma unroll 1
                for (int e = 0; e < 8; ++e) { float sacc = 0.f;
#pragma unroll
                    for (int j = 0; j < 8; ++j) { const f32x4 w = *(const f32x4*)(rwT + e * DM + NCOL(j)); sacc += (v[j].x * w.x + v[j].y * w.y) + (v[j].z * w.z + v[j].w * w.w); }
                    const float lg = wave_sum(sacc);
                    if (lg > v0) { v1 = v0; i1 = i0; v0 = lg; i0 = e; } else if (lg > v1) { v1 = lg; i1 = e; } }
                if (F.lane == 0) {
                    const float w1 = 1.0f / (1.0f + __expf(v0 - v1)), w0 = 1.0f - w1;
                    F_top_e[row * 2 + 0] = i0; F_top_e[row * 2 + 1] = i1; F_gatew[row * 2 + 0] = w0; F_gatew[row * 2 + 1] = w1;
                    atomicAdd((int*)&cnt[i0], 1); atomicAdd((int*)&cnt[i1], 1);
                }
            }
        }
        if (ROUTE) { __syncthreads(); if (F.tid < 8) F_grpcnt[g * 8 + F.tid] = cnt[F.tid]; }
    }
#undef NORM_LOADROW
#undef NORM_LOADMOD
#undef NCOL
}

using pg8::Unit;
struct WinOrder {
    pg8::StaticOrder so; int G, c, tokp0, wp0;
    __device__ void init(int G_, int c_, int layer) { so.init(MTOT, QKVP, G_, c_); G = G_; c = c_; tokp0 = layer == 0 ? INW / 256 : 0; wp0 = layer == 0 ? 0 : MTOT / 256; }
    __device__ bool next(int i, Unit& u) const {
        const int L = i * G + c; constexpr int N0 = (MTOT / 256) * (QKVP / 256), N1 = (HYP / 256) * (MTOT / 256);
        if (L < N0) { int pm, pn; so.map(L, pm, pn); u.pm = tokp0 + pm; u.pn = wp0 + pn; u.orow = pm * 256; u.ocol = pn * 256; u.kind = 0; return true; }
        if (L < N0 + N1) { const int s = L - N0, tt = s / (HYP / 256), cp = s % (HYP / 256); u.pm = wp0 + QKVP / 256 + cp; u.pn = tokp0 + tt; u.orow = cp * 256; u.ocol = tt * 256; u.kind = 1; return true; }
        return false;
    }
    __device__ __forceinline__ void a_ready(const Unit&) const {}
    __device__ __forceinline__ void done(const Unit&) const {}
};
struct EpiIn {
    static constexpr bool PERM = true;
    bf16* proj; bf16* hyT; const float* ropec; const float* ropes;
    __device__ __forceinline__ void operator()(pg8::f32x4 (&acc)[2][2][4][2], const Unit& u, int wr, int wc, int fr, int fq) const {
        const bool tr = u.kind != 0; bf16* base = tr ? hyT : proj; const int ldc = tr ? MTOT : QKVP;
        const int row0 = u.orow + wr * 64 + fr, col0 = u.ocol + wc * 32 + 8 * fq;
        const bool qk = !tr && u.ocol < 1280; const float qs = (!tr && u.ocol < 1024) ? 0.088388347648318440f : 1.0f;
        const int g = 4 * wc + fq, hf = g >> 3, i0 = (g & 7) * 4;
        f32x4 cs[8], sn[8];
#pragma unroll
        for (int q = 0; q < 8; ++q) { const int row = row0 + (q >> 2) * 128 + (q & 3) * 16; cs[q] = (f32x4){1.f, 1.f, 1.f, 1.f}; sn[q] = (f32x4){0.f, 0.f, 0.f, 0.f};
            if (qk && row < NLAT) { const int t = row & (SEQ - 1), pos = hf ? (t & 63) : (t >> 6); cs[q] = *(const f32x4*)(ropec + pos * 32 + i0); sn[q] = *(const f32x4*)(ropes + pos * 32 + i0); } }
#pragma unroll
        for (int ai = 0; ai < 2; ++ai)
#pragma unroll
            for (int m = 0; m < 4; ++m) { const int row = row0 + ai * 128 + m * 16; bf16* rowp = base + (size_t)row * ldc + col0;
#pragma unroll
                for (int bj = 0; bj < 2; ++bj) { f32x4 v0 = acc[ai][bj][m][0], v1 = acc[ai][bj][m][1];
                    if (qk) { const f32x4 y0 = (v0 * cs[ai * 4 + m] - v1 * sn[ai * 4 + m]) * qs, y1 = (v1 * cs[ai * 4 + m] + v0 * sn[ai * 4 + m]) * qs; v0 = y0; v1 = y1; }
                    v4u w; w.x = pg8::cvt_pk_bf16(v0[0], v0[1]); w.y = pg8::cvt_pk_bf16(v0[2], v0[3]); w.z = pg8::cvt_pk_bf16(v1[0], v1[1]); w.w = pg8::cvt_pk_bf16(v1[2], v1[3]);
                    *(v4u*)(rowp + bj * 128) = w; } }
    }
};
template <bool SRC32> struct EpiResid {
    static constexpr bool PERM = false;
    const float* lat_old; const float* ctx_old; bf16* x16; const float* gate; float asc;
    __device__ __forceinline__ void operator()(pg8::f32x4 (&acc)[2][2][4][2], const Unit& u, int wr, int wc, int fr, int fq) const {
        const int row0 = u.orow + wr * 64 + fr, col0 = u.ocol + wc * 32 + 4 * fq;
        const bool cx = u.orow >= NLAT;
        const float* src0 = cx ? ctx_old + (size_t)(row0 - NLAT) * DM : lat_old + (size_t)row0 * DM; bf16* dst0 = x16 + (size_t)row0 * DM;
        const float* gp = gate + (size_t)(cx ? 4 : (u.orow >> 13)) * MODW + col0;
        f32x4 gv[2][2];
#pragma unroll
        for (int bj = 0; bj < 2; ++bj)
#pragma unroll
            for (int n = 0; n < 2; ++n) gv[bj][n] = *(const f32x4*)(gp + bj * 128 + n * 16) * asc;
#pragma unroll
        for (int ai = 0; ai < 2; ++ai) {
            f32x4 xo[4][2][2];
#pragma unroll
            for (int m = 0; m < 4; ++m)
#pragma unroll
                for (int bj = 0; bj < 2; ++bj)
#pragma unroll
                    for (int n = 0; n < 2; ++n) { const size_t o = (size_t)(ai * 128 + m * 16) * DM + col0 + bj * 128 + n * 16;
                        if (SRC32) xo[m][bj][n] = *(const f32x4*)(src0 + o);
                        else { const v2u p = *(const v2u*)(dst0 + o); xo[m][bj][n] = (f32x4){__uint_as_float(p.x << 16), __uint_as_float(p.x & 0xffff0000u), __uint_as_float(p.y << 16), __uint_as_float(p.y & 0xffff0000u)}; } }
#pragma unroll
            for (int m = 0; m < 4; ++m)
#pragma unroll
                for (int bj = 0; bj < 2; ++bj)
#pragma unroll
                    for (int n = 0; n < 2; ++n) { const f32x4 y = xo[m][bj][n] + gv[bj][n] * acc[ai][bj][m][n];
                        *(v2u*)(dst0 + (size_t)(ai * 128 + m * 16) * DM + col0 + bj * 128 + n * 16) = (v2u){pg8::cvt_pk_bf16(y[0], y[1]), pg8::cvt_pk_bf16(y[2], y[3])}; }
            asm volatile("" ::: "memory"); }
    }
};
struct EpiSwiglu {
    static constexpr bool PERM = true;
    bf16* H; float wscale; int f8out;
    __device__ __forceinline__ void operator()(pg8::f32x4 (&acc)[2][2][4][2], const Unit& u, int wr, int wc, int fr, int fq) const {
        const int row0 = u.orow + wr * 64 + fr, col0 = (u.ocol >> 1) + wc * 32 + 8 * fq;
#pragma unroll
        for (int ai = 0; ai < 2; ++ai)
#pragma unroll
            for (int m = 0; m < 4; ++m) { bf16* rowp = H + (size_t)(row0 + ai * 128 + m * 16) * DFF + col0;
                float o[8];
#pragma unroll
                for (int n = 0; n < 2; ++n)
#pragma unroll
                    for (int j = 0; j < 4; ++j) { const float gt = acc[ai][0][m][n][j] * wscale, up = acc[ai][1][m][n][j] * wscale; o[n * 4 + j] = gt * __builtin_amdgcn_rcpf(1.0f + __expf(-gt)) * up; }
                if (f8out) { int p0 = 0, p1 = 0; p0 = __builtin_amdgcn_cvt_pk_fp8_f32(o[0], o[1], p0, false); p0 = __builtin_amdgcn_cvt_pk_fp8_f32(o[2], o[3], p0, true); p1 = __builtin_amdgcn_cvt_pk_fp8_f32(o[4], o[5], p1, false); p1 = __builtin_amdgcn_cvt_pk_fp8_f32(o[6], o[7], p1, true);
                    *(v2u*)((unsigned char*)H + (size_t)(row0 + ai * 128 + m * 16) * DFF + col0) = (v2u){(unsigned)p0, (unsigned)p1}; }
                else { v4u w; w.x = pg8::cvt_pk_bf16(o[0], o[1]); w.y = pg8::cvt_pk_bf16(o[2], o[3]); w.z = pg8::cvt_pk_bf16(o[4], o[5]); w.w = pg8::cvt_pk_bf16(o[6], o[7]);
                *(v4u*)rowp = w; } }
    }
};
struct EpiBf16Plain {
    static constexpr bool PERM = true;
    bf16* O; int ldc; float sc;
    __device__ __forceinline__ void operator()(pg8::f32x4 (&acc)[2][2][4][2], const Unit& u, int wr, int wc, int fr, int fq) const {
        const int row0 = u.orow + wr * 64 + fr, col0 = u.ocol + wc * 32 + 8 * fq;
#pragma unroll
        for (int ai = 0; ai < 2; ++ai)
#pragma unroll
            for (int m = 0; m < 4; ++m) { bf16* rowp = O + (size_t)(row0 + ai * 128 + m * 16) * ldc + col0;
#pragma unroll
                for (int bj = 0; bj < 2; ++bj) { const f32x4 v0 = acc[ai][bj][m][0] * sc, v1 = acc[ai][bj][m][1] * sc;
                    v4u w; w.x = pg8::cvt_pk_bf16(v0[0], v0[1]); w.y = pg8::cvt_pk_bf16(v0[2], v0[3]); w.z = pg8::cvt_pk_bf16(v1[0], v1[1]); w.w = pg8::cvt_pk_bf16(v1[2], v1[3]);
                    *(v4u*)(rowp + bj * 128) = w; } }
    }
};
struct MoeOrder {
    int G, c, p_lo, np, nN, a_off, o_off; const int* ps;
    __device__ bool next(int i, Unit& u) const {
        const int L = i * G + c; if (L >= np * nN) return false;
        const int nig = 8 * nN, gid = L / nig, fm = gid * 8, gsz = (np - fm) < 8 ? (np - fm) : 8, lp = fm + (L % nig) % gsz, j = (L % nig) / gsz;
        const int p = p_lo + lp; int e = 0;
#pragma unroll
        for (int q = 1; q < 8; ++q) e += (p >= ps[q]) ? 1 : 0;
        u.pm = p - a_off; u.pn = e * nN + j; u.orow = (p - o_off) * 256; u.ocol = j * 256; u.kind = e; return true;
    }
    __device__ __forceinline__ void a_ready(const Unit&) const {}
    __device__ __forceinline__ void done(const Unit&) const {}
};

__device__ __forceinline__ float hy_short(const bf16* row, int t, int L, float w0, float w1, float w2, float bb) {
    const float um = t > 0 ? bf2f(row[t - 1]) : 0.f, u0 = bf2f(row[t]), up = t < L - 1 ? bf2f(row[t + 1]) : 0.f;
    return w0 * um + w1 * u0 + w2 * up + bb;
}
__device__ __forceinline__ void pool_unit(Frame& F, int layer, int tile, int g) {
    typedef short bf16x8v __attribute__((ext_vector_type(8)));
    typedef float f32x16v __attribute__((ext_vector_type(16)));
    constexpr int PITCH = 272;
    char* Ul = (char*)F.ldsg;
    char* Dl = Ul + 144 * 256;
    char* Wl = Dl + 128 * PITCH;
    const int row0 = tile * 128; const bool cx = row0 >= NLAT; const int L = cx ? CTXL : SEQ;
    const int seq0 = cx ? NLAT + ((row0 - NLAT) / CTXL) * CTXL : (row0 / SEQ) * SEQ, t0 = row0 - seq0;
    const int win = 2 << g, tid = F.tid;
    __syncthreads();
    for (int i = tid; i < 144 * 16; i += NTHR) { const int r = i >> 4, ch = i & 15, t = t0 - 8 + r; v4u v = (v4u){0u, 0u, 0u, 0u};
        if (t >= 0 && t < L) v = *(const v4u*)(F_proj + (size_t)(seq0 + t) * QKVP + 1536 + g * 128 + ch * 8);
        *(v4u*)(Ul + r * 256 + ch * 16) = v; }
    { const bf16* wt = (const bf16*)(F.ws + WS_POOLWT) + (size_t)(layer * 4 + g) * 16384;
      for (int i = tid; i < 128 * 16; i += NTHR) { const int n = i >> 4, ch = i & 15; *(v4u*)(Wl + n * PITCH + ch * 16) = *(const v4u*)(wt + n * 128 + ch * 8); } }
    __syncthreads();
    { const int tt = tid >> 2, cb = (tid & 3) * 32, t = t0 + tt; int lo = t - win / 2, hi = t + win - win / 2; lo = lo < 0 ? 0 : lo; hi = hi > L ? L : hi;
      const float inv = 1.0f / (float)(hi - lo);
#pragma unroll
      for (int q = 0; q < 4; ++q) { float s[8];
#pragma unroll
          for (int k = 0; k < 8; ++k) s[k] = 0.f;
          for (int r = lo; r < hi; ++r) { const v4u v = *(const v4u*)(Ul + (r - t0 + 8) * 256 + (cb + 8 * q) * 2);
              s[0] += __uint_as_float(v.x << 16); s[1] += __uint_as_float(v.x & 0xffff0000u); s[2] += __uint_as_float(v.y << 16); s[3] += __uint_as_float(v.y & 0xffff0000u);
              s[4] += __uint_as_float(v.z << 16); s[5] += __uint_as_float(v.z & 0xffff0000u); s[6] += __uint_as_float(v.w << 16); s[7] += __uint_as_float(v.w & 0xffff0000u); }
          const v4u c = *(const v4u*)(Ul + (tt + 8) * 256 + (cb + 8 * q) * 2);
          v4u o; o.x = pk2(s[0] * inv - __uint_as_float(c.x << 16), s[1] * inv - __uint_as_float(c.x & 0xffff0000u)); o.y = pk2(s[2] * inv - __uint_as_float(c.y << 16), s[3] * inv - __uint_as_float(c.y & 0xffff0000u));
          o.z = pk2(s[4] * inv - __uint_as_float(c.z << 16), s[5] * inv - __uint_as_float(c.z & 0xffff0000u)); o.w = pk2(s[6] * inv - __uint_as_float(c.w << 16), s[7] * inv - __uint_as_float(c.w & 0xffff0000u));
          *(v4u*)(Dl + tt * PITCH + (cb + 8 * q) * 2) = o; } }
    __syncthreads();
    { const int w = F.wave, lane = F.lane, r32 = lane & 31, hi = lane >> 5, mt = w & 3, nh = w >> 2;
      f32x16v acc0 = {}, acc1 = {};
#pragma unroll
      for (int ks = 0; ks < 8; ++ks) { const int kb = (16 * ks + 8 * hi) * 2;
          const bf16x8v a = *(const bf16x8v*)(Dl + (32 * mt + r32) * PITCH + kb);
          const bf16x8v b0 = *(const bf16x8v*)(Wl + (64 * nh + r32) * PITCH + kb), b1 = *(const bf16x8v*)(Wl + (64 * nh + 32 + r32) * PITCH + kb);
          acc0 = __builtin_amdgcn_mfma_f32_32x32x16_bf16(a, b0, acc0, 0, 0, 0); acc1 = __builtin_amdgcn_mfma_f32_32x32x16_bf16(a, b1, acc1, 0, 0, 0); }
      const float* ps = FIN(IN_POOLS) + layer * POOLW + g * 128 + 64 * nh; const float s0 = ps[r32], s1 = ps[32 + r32];
      float* op = F_pool + (size_t)(row0 + 32 * mt) * POOLW + g * 128 + 64 * nh + r32;
#pragma unroll
      for (int r = 0; r < 16; ++r) { const int m = (r & 3) + 8 * (r >> 2) + 4 * hi; op[(size_t)m * POOLW] = acc0[r] * s0; op[(size_t)m * POOLW + 32] = acc1[r] * s1; } }
}
template <int L>
__device__ __forceinline__ void hyena_unit(Frame& F, int layer, int seq0, int c) {
    float* zb = (float*)F.ldsg; float* zn = zb + L; float* H = zn + L;
    float* w3s = H + 2 * L + 32;
    const float* a2 = L == SEQ ? F_a2 + (size_t)layer * SEQ * 64 : F_a2c;
    const float* cw = FIN(IN_HCW) + layer * 3 * HYP; const float* cb = FIN(IN_HCB) + layer * HYP;
    const bf16* vrow = F_hyT + (size_t)c * MTOT + seq0;
    const float mind = -4.605170185988091f / 1.5f, maxd = -4.605170185988091f / 0.3f;
    const float adelta = fabsf(mind + (float)c * ((maxd - mind) / 511.0f));
    __syncthreads();
    { const float w0 = cw[c], w1 = cw[HYP + c], w2 = cw[2 * HYP + c], bb = cb[c];
      for (int t = F.tid; t < L; t += NTHR) zb[t] = hy_short(vrow, t, L, w0, w1, w2, bb); }
#pragma unroll
    for (int o = 0; o < 2; ++o) {
        float* zin = o == 0 ? zb : zn; float* zout = o == 0 ? zn : zb;
        const int jf = o * 1024 + c, jb = o * 1024 + 512 + c;
        if (F.tid < 64) w3s[F.tid] = FIN(IN_FW3)[((size_t)layer * 64 + F.tid) * 2048 + jf];
        else if (F.tid < 128) w3s[F.tid] = FIN(IN_FW3)[((size_t)layer * 64 + (F.tid - 64)) * 2048 + jb];
        if (F.tid < 16) { H[F.tid] = 0.f; H[2 * L + 16 + F.tid] = 0.f; }
        if (F.tid == 16) H[2 * L + 15] = 0.f;
        __syncthreads();
        { const float b3f = FIN(IN_FB3)[layer * 2048 + jf], b3b = FIN(IN_FB3)[layer * 2048 + jb];
          for (int m = F.tid; m < L; m += NTHR) { float sf = 0.f, sb = 0.f;
#pragma unroll
              for (int q = 0; q < 16; ++q) { const f32x4 a = (f32x4){a2[(size_t)(4 * q) * L + m], a2[(size_t)(4 * q + 1) * L + m], a2[(size_t)(4 * q + 2) * L + m], a2[(size_t)(4 * q + 3) * L + m]}; const f32x4 wf = *(const f32x4*)(w3s + 4 * q), wb = *(const f32x4*)(w3s + 64 + 4 * q);
                  sf += (a.x * wf.x + a.y * wf.y) + (a.z * wf.z + a.w * wf.w); sb += (a.x * wb.x + a.y * wb.y) + (a.z * wb.z + a.w * wb.w); }
              const float dec = __expf(-((float)m / (float)(L - 1)) * adelta);
              H[L + 15 + m] = (sf + b3f) * dec; if (m >= 1) H[L + 15 - m] = (sb + b3b) * dec; } }
        __syncthreads();
        const int ch = (o + 1) * HYW + c; const bf16* xrow = F_hyT + (size_t)ch * MTOT + seq0;
        const float w0 = cw[ch], w1 = cw[HYP + ch], w2 = cw[2 * HYP + ch], bb = cb[ch], hb = FIN(IN_HBIAS)[layer * 1024 + o * 512 + c];
        if constexpr (L == SEQ) {
            const int t0 = 16 * F.tid; float acc[16];
#pragma unroll
            for (int i = 0; i < 16; ++i) acc[i] = 0.f;
            for (int s0 = 0; s0 < L; s0 += 16) {
                const float* hp = H + (t0 - s0 + L); float hw[32], zc[16];
#pragma unroll
                for (int q = 0; q < 8; ++q) { const f32x4 v = *(const f32x4*)(hp + 4 * q); hw[4 * q] = v.x; hw[4 * q + 1] = v.y; hw[4 * q + 2] = v.z; hw[4 * q + 3] = v.w; }
#pragma unroll
                for (int q = 0; q < 4; ++q) { const f32x4 v = *(const f32x4*)(zin + s0 + 4 * q); zc[4 * q] = v.x; zc[4 * q + 1] = v.y; zc[4 * q + 2] = v.z; zc[4 * q + 3] = v.w; }
#pragma unroll
                for (int i = 0; i < 16; ++i)
#pragma unroll
                    for (int k = 0; k < 16; ++k) acc[i] += zc[k] * hw[15 + i - k];
            }
#pragma unroll
            for (int i = 0; i < 16; ++i) { const int t = t0 + i; const float xo = hy_short(xrow, t, L, w0, w1, w2, bb); const float zv = xo * (acc[i] + zin[t] * hb);
                if (o == 0) zout[t] = zv; else F_zT[(size_t)c * MTOT + seq0 + t] = zv; }
        } else {
            if (F.tid < L) { const int t = F.tid; float a = 0.f;
                for (int s = 0; s < L; ++s) a += zin[s] * H[t - s + L + 15];
                const float xo = hy_short(xrow, t, L, w0, w1, w2, bb); const float zv = xo * (a + zin[t] * hb);
                if (o == 0) zout[t] = zv; else F_zT[(size_t)c * MTOT + seq0 + t] = zv; }
        }
        __syncthreads();
    }
}
__device__ __forceinline__ unsigned launder_u(unsigned v);
namespace hyf {
constexpr int N = 16384, LQ = 8192;
__device__ __forceinline__ int opq(int v) { asm volatile("" : "+v"(v)); return v; }
__device__ __forceinline__ constexpr float c32(int i) { constexpr float t[16] = {1.000000000e+00f, 9.807852804e-01f, 9.238795325e-01f, 8.314696123e-01f, 7.071067812e-01f, 5.555702330e-01f, 3.826834324e-01f, 1.950903220e-01f,
    0.0f, -1.950903220e-01f, -3.826834324e-01f, -5.555702330e-01f, -7.071067812e-01f, -8.314696123e-01f, -9.238795325e-01f, -9.807852804e-01f}; return t[i]; }
__device__ __forceinline__ constexpr float s32(int i) { constexpr float t[16] = {0.000000000e+00f, 1.950903220e-01f, 3.826834324e-01f, 5.555702330e-01f, 7.071067812e-01f, 8.314696123e-01f, 9.238795325e-01f, 9.807852804e-01f,
    1.000000000e+00f, 9.807852804e-01f, 9.238795325e-01f, 8.314696123e-01f, 7.071067812e-01f, 5.555702330e-01f, 3.826834324e-01f, 1.950903220e-01f}; return t[i]; }
__device__ __forceinline__ constexpr int brev(int i, int bits) { int r = 0; for (int k = 0; k < bits; ++k) r |= ((i >> k) & 1) << (bits - 1 - k); return r; }
template <int R, bool INV> __device__ __forceinline__ void fft_reg(float (&re)[R], float (&im)[R]) {
#pragma unroll
    for (int len = R; len >= 2; len >>= 1) { const int half = len / 2;
#pragma unroll
        for (int blk = 0; blk < R; blk += len)
#pragma unroll
            for (int i = 0; i < half; ++i) { const int p = blk + i, q = p + half;
                const float ur = re[p] + re[q], ui = im[p] + im[q], vr = re[p] - re[q], vi = im[p] - im[q];
                const float c = c32(i * (32 / len)), sn = INV ? s32(i * (32 / len)) : -s32(i * (32 / len));
                re[p] = ur; im[p] = ui; re[q] = vr * c - vi * sn; im[q] = vr * sn + vi * c; } }
}
template <bool INV> __device__ __forceinline__ void tw_build(const f32x2* __restrict__ TW, int e, float (&lr)[8], float (&li)[8], float (&hr)[4], float (&hi)[4]) {
    (void)TW; f32x2 b0, b1, b2, b3, b4; const float sg = INV ? 1.0f : -1.0f;
    { const float x = (float)(e & (N - 1)) * (1.0f / N); b0.x = __builtin_amdgcn_cosf(x); b0.y = sg * __builtin_amdgcn_sinf(x); }
    { const float x = (float)((2 * e) & (N - 1)) * (1.0f / N); b1.x = __builtin_amdgcn_cosf(x); b1.y = sg * __builtin_amdgcn_sinf(x); }
    { const float x = (float)((4 * e) & (N - 1)) * (1.0f / N); b2.x = __builtin_amdgcn_cosf(x); b2.y = sg * __builtin_amdgcn_sinf(x); }
    { const float x = (float)((8 * e) & (N - 1)) * (1.0f / N); b3.x = __builtin_amdgcn_cosf(x); b3.y = sg * __builtin_amdgcn_sinf(x); }
    { const float x = (float)((16 * e) & (N - 1)) * (1.0f / N); b4.x = __builtin_amdgcn_cosf(x); b4.y = sg * __builtin_amdgcn_sinf(x); }
    lr[0] = 1.f; li[0] = 0.f; lr[1] = b0.x; li[1] = b0.y; lr[2] = b1.x; li[2] = b1.y; lr[3] = b0.x * b1.x - b0.y * b1.y; li[3] = b0.x * b1.y + b0.y * b1.x;
    lr[4] = b2.x; li[4] = b2.y; lr[5] = b2.x * b0.x - b2.y * b0.y; li[5] = b2.x * b0.y + b2.y * b0.x; lr[6] = b2.x * b1.x - b2.y * b1.y; li[6] = b2.x * b1.y + b2.y * b1.x;
    lr[7] = b2.x * lr[3] - b2.y * li[3]; li[7] = b2.x * li[3] + b2.y * lr[3];
    hr[0] = 1.f; hi[0] = 0.f; hr[1] = b3.x; hi[1] = b3.y; hr[2] = b4.x; hi[2] = b4.y; hr[3] = b3.x * b4.x - b3.y * b4.y; hi[3] = b3.x * b4.y + b3.y * b4.x;
}
#define HYF_TWMUL(k, xr, xi) do { const int _l = (k) & 7, _h = (k) >> 3; float _wr, _wi; \
    if (_l == 0) { _wr = hr[_h]; _wi = hi[_h]; } else if (_h == 0) { _wr = lr[_l]; _wi = li[_l]; } else { _wr = lr[_l] * hr[_h] - li[_l] * hi[_h]; _wi = lr[_l] * hi[_h] + li[_l] * hr[_h]; } \
    if ((k) != 0) { const float _t = (xr) * _wr - (xi) * _wi; (xi) = (xr) * _wi + (xi) * _wr; (xr) = _t; } } while (0)
__device__ __forceinline__ int phA(int a, int b) { return a + (a >> 4) + 560 * b; }
__device__ __forceinline__ int phB(int kb, int a2, int b2) { return 560 * kb + a2 + 17 * b2; }
__device__ __forceinline__ int phC(int g, int a3) { return 17 * g + 16 * (g >> 5) + a3; }
constexpr int XWORDS = 17920;
__device__ __forceinline__ void passA_fwd(f32x2* X, const f32x2* TW, float (&re)[32], float (&im)[32], int a) {
    fft_reg<32, false>(re, im);
    float lr[8], li[8], hr[4], hi[4]; tw_build<false>(TW, a, lr, li, hr, hi);
#pragma unroll
    for (int i = 0; i < 32; ++i) { const int kb = brev(i, 5); HYF_TWMUL(kb, re[i], im[i]); X[phA(a, kb)] = (f32x2){re[i], im[i]}; }
}
__device__ __forceinline__ void passB_fwd(f32x2* X, const f32x2* TW, int t) {
    const int kb = t >> 4, a2 = t & 15; float re[32], im[32];
#pragma unroll
    for (int b = 0; b < 32; ++b) { const f32x2 v = X[phB(kb, a2, b)]; re[b] = v.x; im[b] = v.y; }
    fft_reg<32, false>(re, im);
    float lr[8], li[8], hr[4], hi[4]; tw_build<false>(TW, 32 * a2, lr, li, hr, hi);
#pragma unroll
    for (int i = 0; i < 32; ++i) { const int k2 = brev(i, 5); HYF_TWMUL(k2, re[i], im[i]); X[phB(kb, a2, k2)] = (f32x2){re[i], im[i]}; }
}
__device__ __forceinline__ void passB_inv(f32x2* X, const f32x2* TW, int t) {
    const int kb = t >> 4, a2 = t & 15; float re[32], im[32];
    float lr[8], li[8], hr[4], hi[4]; tw_build<true>(TW, 32 * a2, lr, li, hr, hi);
#pragma unroll
    for (int k2 = 0; k2 < 32; ++k2) { const f32x2 v = X[phB(kb, a2, k2)]; re[k2] = v.x; im[k2] = v.y; HYF_TWMUL(k2, re[k2], im[k2]); }
    fft_reg<32, true>(re, im);
#pragma unroll
    for (int i = 0; i < 32; ++i) X[phB(kb, a2, brev(i, 5))] = (f32x2){re[i], im[i]};
}
__device__ __forceinline__ void passA_inv(const f32x2* X, const f32x2* TW, float (&re)[32], float (&im)[32], int a) {
    float lr[8], li[8], hr[4], hi[4]; tw_build<true>(TW, a, lr, li, hr, hi);
#pragma unroll
    for (int kb = 0; kb < 32; ++kb) { const f32x2 v = X[phA(a, kb)]; re[kb] = v.x; im[kb] = v.y; HYF_TWMUL(kb, re[kb], im[kb]); }
    fft_reg<32, true>(re, im);
}
__device__ __forceinline__ void passC_filter(const f32x2* X, f32x2* __restrict__ K, int g) {
    float re[16], im[16];
#pragma unroll
    for (int a3 = 0; a3 < 16; ++a3) { const f32x2 v = X[phC(g, a3)]; re[a3] = v.x; im[a3] = v.y; }
    fft_reg<16, false>(re, im);
    float kr[16], ki[16];
#pragma unroll
    for (int i = 0; i < 16; ++i) { kr[brev(i, 4)] = re[i] * (1.0f / N); ki[brev(i, 4)] = im[i] * (1.0f / N); }
#pragma unroll
    for (int q = 0; q < 8; ++q) *(f32x4*)(K + 16 * g + 2 * q) = (f32x4){kr[2 * q], ki[2 * q], kr[2 * q + 1], ki[2 * q + 1]};
}
__device__ __forceinline__ void passC_mul(f32x2* X, const f32x2* __restrict__ K, int g) {
    float re[16], im[16];
    f32x4 kv[8];
#pragma unroll
    for (int q = 0; q < 8; ++q) kv[q] = *(const f32x4*)(K + 16 * g + 2 * q);
#pragma unroll
    for (int a3 = 0; a3 < 16; ++a3) { const f32x2 v = X[phC(g, a3)]; re[a3] = v.x; im[a3] = v.y; }
    fft_reg<16, false>(re, im);
    float nr[16], ni[16];
#pragma unroll
    for (int i = 0; i < 16; ++i) { const int ka = brev(i, 4); const float kr = (ka & 1) ? kv[ka >> 1].z : kv[ka >> 1].x, ki = (ka & 1) ? kv[ka >> 1].w : kv[ka >> 1].y;
        nr[ka] = re[i] * kr - im[i] * ki; ni[ka] = re[i] * ki + im[i] * kr; }
    fft_reg<16, true>(nr, ni);
#pragma unroll
    for (int i = 0; i < 16; ++i) X[phC(g, brev(i, 4))] = (f32x2){nr[i], ni[i]};
}
__device__ __forceinline__ void mid_passes(f32x2* X, const f32x2* TW, const f32x2* __restrict__ K, int tid) {
    __syncthreads();
    passB_fwd(X, TW, opq(tid));
    __syncthreads();
#pragma unroll 1
    for (int h2 = 0; h2 < 2; ++h2) passC_mul(X, K, opq(tid) + 512 * h2);
    __syncthreads();
    passB_inv(X, TW, opq(tid));
    __syncthreads();
}
}
#define F_tw ((f32x2*)(F.ws + WS_TW))
#define F_kf ((f32x2*)(F.ws + WS_KF))
__device__ __forceinline__ void hyena_fft_filters(Frame& F, int layer, int c) {
    f32x2* X = (f32x2*)F.ldsg;
    const f32x2* TW = F_tw; f32x2* KF = F_kf + (size_t)F.bid * 2 * hyf::N;
    const float* cw = FIN(IN_HCW) + layer * 3 * HYP; const float* cb = FIN(IN_HCB) + layer * HYP;
    const float mind = -4.605170185988091f / 1.5f, maxd = -4.605170185988091f / 0.3f;
    const float adelta = fabsf(mind + (float)c * ((maxd - mind) / 511.0f));
    const int tid = hyf::opq(F.tid);
    { typedef short bf16x8v __attribute__((ext_vector_type(8)));
      const int lane = tid & 63, wv = tid >> 6, fr = lane & 15, fq = lane >> 4;
      bf16x8v wf0 = {0, 0, 0, 0, 0, 0, 0, 0}, wf1 = {0, 0, 0, 0, 0, 0, 0, 0};
      if (fr < 4) { const int j = (fr >> 1) * 1024 + (fr & 1) * 512 + c; const float* wp = FIN(IN_FW3) + (size_t)layer * 64 * 2048 + j;
#pragma unroll
          for (int e = 0; e < 8; ++e) { wf0[e] = (short)f2bf(wp[(size_t)(8 * fq + e) * 2048]); wf1[e] = (short)f2bf(wp[(size_t)(32 + 8 * fq + e) * 2048]); } }
      const bf16* a2b = (const bf16*)(F.ws + WS_A2B) + (size_t)layer * SEQ * 64;
      float* Sf = (float*)(F.ws + WS_HS) + (size_t)launder_u((unsigned)F.bid) * 6 * SEQ;
      const float b3a = FIN(IN_FB3)[layer * 2048 + c], b3b = FIN(IN_FB3)[layer * 2048 + 512 + c], b3c = FIN(IN_FB3)[layer * 2048 + 1024 + c], b3d = FIN(IN_FB3)[layer * 2048 + 1536 + c];
      __syncthreads();
      if (tid == 256) X[hyf::phA(0, 16)] = (f32x2){0.f, 0.f};
#pragma unroll 2
      for (int blk = wv; blk < SEQ / 16; blk += NWAVES) { const int m = 16 * blk + fr;
          const bf16x8v a0 = *(const bf16x8v*)(a2b + (size_t)m * 64 + 8 * fq), a1 = *(const bf16x8v*)(a2b + (size_t)m * 64 + 32 + 8 * fq);
          f32x4 acc = (f32x4){0.f, 0.f, 0.f, 0.f};
          acc = __builtin_amdgcn_mfma_f32_16x16x32_bf16(wf0, a0, acc, 0, 0, 0); acc = __builtin_amdgcn_mfma_f32_16x16x32_bf16(wf1, a1, acc, 0, 0, 0);
          if (fq == 0) { const float dec = __expf(-((float)m / (float)(SEQ - 1)) * adelta);
              X[hyf::phA(m & 511, m >> 9)] = (f32x2){(acc.x + b3a) * dec, 0.f};
              if (m >= 1) { const int p = hyf::N - m; X[hyf::phA(p & 511, p >> 9)] = (f32x2){(acc.y + b3b) * dec, 0.f}; }
              Sf[m] = (acc.z + b3c) * dec; Sf[SEQ + m] = (acc.w + b3d) * dec; } }
#pragma unroll 1
      for (int o = 0; o < 2; ++o) {
          if (o == 1) {
              __syncthreads();
              if (tid == 256) X[hyf::phA(0, 16)] = (f32x2){0.f, 0.f};
              for (int blk = wv; blk < SEQ / 16; blk += NWAVES) if (fq == 0) { const int m = 16 * blk + fr; X[hyf::phA(m & 511, m >> 9)] = (f32x2){Sf[m], 0.f};
                  if (m >= 1) { const int p = hyf::N - m; X[hyf::phA(p & 511, p >> 9)] = (f32x2){Sf[SEQ + m], 0.f}; } }
          }
          __syncthreads();
          { float re[32], im[32];
#pragma unroll
            for (int b = 0; b < 32; ++b) { const f32x2 v = X[hyf::phA(tid, b)]; re[b] = v.x; im[b] = v.y; }
            hyf::passA_fwd(X, TW, re, im, hyf::opq(tid)); }
          __syncthreads();
          hyf::passB_fwd(X, TW, hyf::opq(tid));
          __syncthreads();
          hyf::passC_filter(X, KF + (size_t)o * hyf::N, hyf::opq(tid)); hyf::passC_filter(X, KF + (size_t)o * hyf::N, hyf::opq(tid) + 512);
      } }
    asm volatile("s_waitcnt vmcnt(0)" ::: "memory");
    __syncthreads();
}
__device__ __forceinline__ float bld_f32(__amdgpu_buffer_rsrc_t r, unsigned voff, unsigned soff) { return __builtin_bit_cast(float, __builtin_amdgcn_raw_buffer_load_b32(r, voff, soff, 0)); }
__device__ __forceinline__ float bld_b16f(__amdgpu_buffer_rsrc_t r, unsigned voff, unsigned soff) { return __uint_as_float((unsigned)(unsigned short)__builtin_amdgcn_raw_buffer_load_b16(r, voff, soff, 0) << 16); }
__device__ __forceinline__ void bst_f32(__amdgpu_buffer_rsrc_t r, unsigned voff, unsigned soff, float v) { __builtin_amdgcn_raw_buffer_store_b32(__builtin_bit_cast(unsigned, v), r, voff, soff, 0); }
__device__ __forceinline__ float bld_bf16(__amdgpu_buffer_rsrc_t r, unsigned voff, unsigned soff) { return __uint_as_float(((unsigned)__builtin_amdgcn_raw_buffer_load_b16(r, voff, soff, 0)) << 16); }
__device__ __forceinline__ float hy_short_b(__amdgpu_buffer_rsrc_t r, unsigned rowb, unsigned v2, int tid, int b, float w0, float w1, float w2, float bb) {
    const unsigned so = rowb + 1024u * (unsigned)b - 2u;
    float um = bld_bf16(r, v2, so), u0 = bld_bf16(r, v2, so + 2u), up = bld_bf16(r, v2, so + 4u);
    if (b == 0 && tid == 0) um = 0.f; if (b == 15 && tid == 511) up = 0.f;
    return w0 * um + w1 * u0 + w2 * up + bb;
}
__device__ __forceinline__ void hyena_fft_data(Frame& F, int layer, int c) {
    f32x2* X = (f32x2*)F.ldsg;
    const f32x2* TW = F_tw; const f32x2* KF = F_kf + (size_t)F.bid * 2 * hyf::N;
    const float* cw = FIN(IN_HCW) + layer * 3 * HYP; const float* cb = FIN(IN_HCB) + layer * HYP;
    const int tid = hyf::opq(F.tid); const unsigned v4 = 4u * (unsigned)tid, v2 = 2u * (unsigned)tid;
    const __amdgpu_buffer_rsrc_t R = __builtin_amdgcn_make_buffer_rsrc((void*)F.ws, 0, (unsigned)WS_END, 0x00020000);
    const unsigned Sb = (unsigned)(WS_HS + (size_t)F.bid * 6 * SEQ * 4);
    const float hb0 = FIN(IN_HBIAS)[layer * 1024 + c], hb1 = FIN(IN_HBIAS)[layer * 1024 + 512 + c];
#pragma unroll 1
    for (int pr = 0; pr < 2; ++pr) {
        const unsigned oab = (unsigned)(WS_ZT + ((size_t)c * MTOT + (size_t)(2 * pr) * SEQ) * 4), obb = oab + SEQ * 4;
#pragma unroll 1
        for (int r = 0; r < 3; ++r) { const int ch = r * HYW + c; const unsigned ua = (unsigned)(WS_HYT + ((size_t)ch * MTOT + (size_t)(2 * pr) * SEQ) * 2), ub = ua + SEQ * 2;
            const float w0 = cw[ch], w1 = cw[HYP + ch], w2 = cw[2 * HYP + ch], bb = cb[ch];
#pragma unroll
            for (int b = 0; b < 16; ++b) { bst_f32(R, v4, Sb + (unsigned)((2 * r) * SEQ * 4 + 2048 * b), hy_short_b(R, ua, v2, tid, b, w0, w1, w2, bb));
                                           bst_f32(R, v4, Sb + (unsigned)((2 * r + 1) * SEQ * 4 + 2048 * b), hy_short_b(R, ub, v2, tid, b, w0, w1, w2, bb)); } }
#pragma unroll 1
        for (int o = 0; o < 2; ++o) {
            const unsigned ina = o == 0 ? Sb : oab, inb = o == 0 ? Sb + SEQ * 4 : obb, ga = Sb + (unsigned)((2 + 2 * o) * SEQ * 4), gb = ga + SEQ * 4;
            const float hb = o == 0 ? hb0 : hb1;
            { float re[32], im[32];
#pragma unroll
              for (int b = 0; b < 16; ++b) { re[b] = bld_f32(R, v4, ina + 2048u * b); im[b] = bld_f32(R, v4, inb + 2048u * b); re[16 + b] = 0.f; im[16 + b] = 0.f; }
              hyf::passA_fwd(X, TW, re, im, hyf::opq(tid)); }
            hyf::mid_passes(X, TW, KF + (size_t)o * hyf::N, tid);
            { float re[32], im[32]; hyf::passA_inv(X, TW, re, im, hyf::opq(tid));
#pragma unroll
              for (int i = 0; i < 32; ++i) { const int b = hyf::brev(i, 5); if (b < 16) { const unsigned q = 2048u * b;
                  const float za = bld_f32(R, v4, ina + q), zb = bld_f32(R, v4, inb + q);
                  bst_f32(R, v4, oab + q, bld_f32(R, v4, ga + q) * (re[i] + za * hb)); bst_f32(R, v4, obb + q, bld_f32(R, v4, gb + q) * (im[i] + zb * hb)); } } }
        }
    }
    __syncthreads();
}
namespace hym {
typedef short bf16x8v __attribute__((ext_vector_type(8)));
typedef float f32x16v __attribute__((ext_vector_type(16)));
constexpr int N = 16384;
constexpr int T_F32F = 0, T_F32I = 8, T_F32IH = 16, T_F16F = 20, T_F16IP = 22, T_NFRAG = 24;
__device__ __forceinline__ int crow(int r, int hi) { return (r & 3) + 8 * (r >> 2) + 4 * hi; }
__device__ __forceinline__ float dft_entry(int f, int lane, int j) {
    const int n = lane & 31, hi = lane >> 5;
    int R, sign, m, k;
    if (f < T_F32IH) { R = 32; sign = f < T_F32I ? -1 : 1; const int q = f & 7, mt = q >> 2, s_ = q & 3; m = 32 * mt + n; k = 16 * s_ + 8 * hi + j; }
    else if (f < T_F16F) { R = 32; sign = 1; const int s_ = f - T_F32IH; m = n < 16 ? n : 32 + (n - 16); k = 16 * s_ + 8 * hi + j; }
    else if (f < T_F16IP) { R = 16; sign = -1; const int s_ = f - T_F16F; m = n; k = 16 * s_ + 8 * hi + j; }
    else { R = 16; sign = 1; const int s_ = f - T_F16IP; m = n; k = crow(8 * s_ + j, hi); }
    const int mp = m / R, mi = m % R, kp = k / R, ki = k % R;
    const double ang = 6.283185307179586476925 * (double)((mi * ki) % R) / (double)R; const double fr = cos(ang), fi = (double)sign * sin(ang);
    return (float)(mp == 0 ? (kp == 0 ? fr : -fi) : (kp == 0 ? fi : fr));
}
__device__ __forceinline__ unsigned cvtpk(float lo, float hi) { unsigned r; asm volatile("v_cvt_pk_bf16_f32 %0, %1, %2" : "=v"(r) : "v"(lo), "v"(hi)); return r; }
__device__ __forceinline__ bf16x8v pack8(const float (&v)[8]) { v4u w; w.x = cvtpk(v[0], v[1]); w.y = cvtpk(v[2], v[3]); w.z = cvtpk(v[4], v[5]); w.w = cvtpk(v[6], v[7]); return __builtin_bit_cast(bf16x8v, w); }
__device__ __forceinline__ bf16x8v afrag(const bf16* tab, int f, int lane) { return *(const bf16x8v*)(tab + ((size_t)f * 64 + lane) * 8); }
__device__ __forceinline__ void ld_F32F(bf16x8v (&fr)[8], const bf16* tab, int lane) {
#pragma unroll
    for (int i = 0; i < 8; ++i) fr[i] = afrag(tab, T_F32F + i, lane); }
__device__ __forceinline__ void ld_F32I(bf16x8v (&fr)[8], const bf16* tab, int lane) {
#pragma unroll
    for (int i = 0; i < 8; ++i) fr[i] = afrag(tab, T_F32I + i, lane); }
__device__ __forceinline__ void ld_A(bf16x8v (&fr)[4], const bf16* tab, int lane, bool from_lds) { fr[0] = afrag(tab, T_F32F + 0, lane); fr[1] = afrag(tab, T_F32F + 4, lane); fr[2] = afrag(tab, T_F32F + (from_lds ? 1 : 2), lane); fr[3] = afrag(tab, T_F32F + 4 + (from_lds ? 1 : 2), lane); }
__device__ __forceinline__ void ld_C(bf16x8v (&fr)[4], const bf16* tab, int lane) { fr[0] = afrag(tab, T_F16F + 0, lane); fr[1] = afrag(tab, T_F16F + 1, lane); fr[2] = afrag(tab, T_F16IP + 0, lane); fr[3] = afrag(tab, T_F16IP + 1, lane); }
__device__ __forceinline__ void ld_AH(bf16x8v (&fr)[4], const bf16* tab, int lane) {
#pragma unroll
    for (int i = 0; i < 4; ++i) fr[i] = afrag(tab, T_F32IH + i, lane); }
using hyf::phA; using hyf::phB; using hyf::phC;
__device__ __forceinline__ void tw5(int e, float sg, f32x2 (&b)[5]) {
#pragma unroll
    for (int j = 0; j < 5; ++j) { const float x = (float)((e << j) & (N - 1)) * (1.0f / N); b[j].x = __builtin_amdgcn_cosf(x); b[j].y = sg * __builtin_amdgcn_sinf(x); }
}
__device__ __forceinline__ f32x2 cmul(f32x2 a, f32x2 b) { return (f32x2){a.x * b.x - a.y * b.y, a.x * b.y + a.y * b.x}; }
__device__ __forceinline__ void tw_rows(int e, float sg, int hi, f32x2 (&lo4)[4], f32x2 (&hi4)[4]) {
    f32x2 b[5]; tw5(e, sg, b);
    const f32x2 t = hi ? b[2] : (f32x2){1.f, 0.f};
    lo4[0] = t; lo4[1] = cmul(t, b[0]); lo4[2] = cmul(t, b[1]); lo4[3] = cmul(lo4[1], b[1]);
    hi4[0] = (f32x2){1.f, 0.f}; hi4[1] = b[3]; hi4[2] = b[4]; hi4[3] = cmul(b[3], b[4]);
}
__device__ __forceinline__ void tw_cols(int e, float sg, int hi, f32x2 (&lo8)[8], f32x2 (&hx)[2]) {
    f32x2 b[5]; tw5(e, sg, b);
    lo8[0] = (f32x2){1.f, 0.f}; lo8[1] = b[0]; lo8[2] = b[1]; lo8[3] = cmul(b[0], b[1]); lo8[4] = b[2]; lo8[5] = cmul(b[2], b[0]); lo8[6] = cmul(b[2], b[1]); lo8[7] = cmul(b[2], lo8[3]);
    hx[0] = hi ? b[3] : (f32x2){1.f, 0.f}; hx[1] = cmul(hx[0], b[4]);
}
#define HYM_MFMA(a, b, c) __builtin_amdgcn_mfma_f32_32x32x16_bf16(a, b, c, 0, 0, 0)
template <bool FROM_LDS>
__device__ __forceinline__ void passA_fwd(f32x2* X, const bf16x8v (&fr)[4], __amdgpu_buffer_rsrc_t R, unsigned ina, unsigned inb, int tid) {
    const int lane = tid & 63, w = tid >> 6, n = lane & 31, hi = lane >> 5;
    const bf16x8v A0a = fr[0], A1a = fr[1], A0b = fr[2], A1b = fr[3];
#pragma unroll
    for (int nt = 0; nt < 2; ++nt) { const int a = 64 * w + 32 * nt + n;
        float u0[8], u1[8];
        if (FROM_LDS) {
#pragma unroll
            for (int j = 0; j < 8; ++j) { u0[j] = X[phA(a, 8 * hi + j)].x; u1[j] = X[phA(a, 16 + 8 * hi + j)].x; }
        } else { const unsigned vo = 2u * (unsigned)a + 8192u * (unsigned)hi;
#pragma unroll
            for (int j = 0; j < 8; ++j) { u0[j] = bld_b16f(R, vo, ina + 1024u * j); u1[j] = bld_b16f(R, vo, inb + 1024u * j); } }
        const bf16x8v B0 = pack8(u0), B1 = pack8(u1);
        f32x16v c0 = {}, c1 = {};
        c0 = HYM_MFMA(A0a, B0, c0); c1 = HYM_MFMA(A1a, B0, c1); c0 = HYM_MFMA(A0b, B1, c0); c1 = HYM_MFMA(A1b, B1, c1);
        f32x2 lo4[4], hi4[4]; tw_rows(a, -1.f, hi, lo4, hi4);
#pragma unroll
        for (int r = 0; r < 16; ++r) { const f32x2 wv = cmul(lo4[r & 3], hi4[r >> 2]); X[phA(a, crow(r, hi))] = cmul((f32x2){c0[r], c1[r]}, wv); } }
}
__device__ __forceinline__ void passB_fwd(f32x2* X, const bf16x8v (&fr)[8], int tid) {
    const int lane = tid & 63, w = tid >> 6, n = lane & 31, hi = lane >> 5;
    bf16x8v A0[4], A1[4];
#pragma unroll
    for (int s_ = 0; s_ < 4; ++s_) { A0[s_] = fr[s_]; A1[s_] = fr[4 + s_]; }
#pragma unroll
    for (int nt = 0; nt < 2; ++nt) { const int v = 64 * w + 32 * nt + n, kb = v >> 4, a2 = v & 15;
        float xr0[8], xi0[8], xr1[8], xi1[8];
#pragma unroll
        for (int j = 0; j < 8; ++j) { const f32x2 p = X[phB(kb, a2, 8 * hi + j)], q = X[phB(kb, a2, 16 + 8 * hi + j)]; xr0[j] = p.x; xi0[j] = p.y; xr1[j] = q.x; xi1[j] = q.y; }
        const bf16x8v B0 = pack8(xr0), B1 = pack8(xr1), B2 = pack8(xi0), B3 = pack8(xi1);
        f32x16v c0 = {}, c1 = {};
        c0 = HYM_MFMA(A0[0], B0, c0); c1 = HYM_MFMA(A1[0], B0, c1); c0 = HYM_MFMA(A0[1], B1, c0); c1 = HYM_MFMA(A1[1], B1, c1);
        c0 = HYM_MFMA(A0[2], B2, c0); c1 = HYM_MFMA(A1[2], B2, c1); c0 = HYM_MFMA(A0[3], B3, c0); c1 = HYM_MFMA(A1[3], B3, c1);
        f32x2 lo4[4], hi4[4]; tw_rows(32 * a2, -1.f, hi, lo4, hi4);
#pragma unroll
        for (int r = 0; r < 16; ++r) { const f32x2 wv = cmul(lo4[r & 3], hi4[r >> 2]); X[phB(kb, a2, crow(r, hi))] = cmul((f32x2){c0[r], c1[r]}, wv); } }
}
__device__ __forceinline__ void passB_inv(f32x2* X, const bf16x8v (&fr)[8], int tid) {
    const int lane = tid & 63, w = tid >> 6, n = lane & 31, hi = lane >> 5;
    bf16x8v A0[4], A1[4];
#pragma unroll
    for (int s_ = 0; s_ < 4; ++s_) { A0[s_] = fr[s_]; A1[s_] = fr[4 + s_]; }
#pragma unroll
    for (int nt = 0; nt < 2; ++nt) { const int v = 64 * w + 32 * nt + n, kb = v >> 4, a2 = v & 15;
        f32x2 lo8[8], hx[2]; tw_cols(32 * a2, 1.f, hi, lo8, hx);
        float xr0[8], xi0[8], xr1[8], xi1[8];
#pragma unroll
        for (int j = 0; j < 8; ++j) { const f32x2 p = cmul(X[phB(kb, a2, 8 * hi + j)], cmul(lo8[j], hx[0])), q = cmul(X[phB(kb, a2, 16 + 8 * hi + j)], cmul(lo8[j], hx[1]));
            xr0[j] = p.x; xi0[j] = p.y; xr1[j] = q.x; xi1[j] = q.y; }
        const bf16x8v B0 = pack8(xr0), B1 = pack8(xr1), B2 = pack8(xi0), B3 = pack8(xi1);
        f32x16v c0 = {}, c1 = {};
        c0 = HYM_MFMA(A0[0], B0, c0); c1 = HYM_MFMA(A1[0], B0, c1); c0 = HYM_MFMA(A0[1], B1, c0); c1 = HYM_MFMA(A1[1], B1, c1);
        c0 = HYM_MFMA(A0[2], B2, c0); c1 = HYM_MFMA(A1[2], B2, c1); c0 = HYM_MFMA(A0[3], B3, c0); c1 = HYM_MFMA(A1[3], B3, c1);
#pragma unroll
        for (int r = 0; r < 16; ++r) X[phB(kb, a2, crow(r, hi))] = (f32x2){c0[r], c1[r]}; }
}
template <bool MUL>
__device__ __forceinline__ void passC(f32x2* X, const bf16x8v (&fr)[4], f32x2* __restrict__ K, int tid) {
    const int lane = tid & 63, w = tid >> 6, n = lane & 31, hi = lane >> 5;
    const bf16x8v F0 = fr[0], F1 = fr[1], I0 = fr[2], I1 = fr[3];
#pragma unroll 2
    for (int nt = 0; nt < 4; ++nt) { const int g = 128 * w + 32 * nt + n;
        f32x4 kv[4];
        if (MUL) { const f32x4* kp = (const f32x4*)(K + 16 * g + 4 * hi); kv[0] = kp[0]; kv[1] = kp[1]; kv[2] = kp[4]; kv[3] = kp[5]; }
        float xr[8], xi[8];
#pragma unroll
        for (int j = 0; j < 8; ++j) { const f32x2 p = X[phC(g, 8 * hi + j)]; xr[j] = p.x; xi[j] = p.y; }
        f32x16v c = {};
        c = HYM_MFMA(F0, pack8(xr), c); c = HYM_MFMA(F1, pack8(xi), c);
        if (MUL) {
            float pr[8], pi[8];
#pragma unroll
            for (int r = 0; r < 8; ++r) { const f32x4 kq = kv[(r >> 2) * 2 + ((r & 3) >> 1)]; const float kr = (r & 1) ? kq.z : kq.x, ki = (r & 1) ? kq.w : kq.y;
                pr[r] = c[r] * kr - c[8 + r] * ki; pi[r] = c[r] * ki + c[8 + r] * kr; }
            f32x16v d = {};
            d = HYM_MFMA(I0, pack8(pr), d); d = HYM_MFMA(I1, pack8(pi), d);
#pragma unroll
            for (int r = 0; r < 8; ++r) X[phC(g, crow(r, hi))] = (f32x2){d[r], d[8 + r]};
        } else {
            f32x4* kp = (f32x4*)(K + 16 * g + 4 * hi); const float sc = 1.0f / N;
            kp[0] = (f32x4){c[0] * sc, c[8] * sc, c[1] * sc, c[9] * sc}; kp[1] = (f32x4){c[2] * sc, c[10] * sc, c[3] * sc, c[11] * sc};
            kp[4] = (f32x4){c[4] * sc, c[12] * sc, c[5] * sc, c[13] * sc}; kp[5] = (f32x4){c[6] * sc, c[14] * sc, c[7] * sc, c[15] * sc};
        } }
}
__device__ __forceinline__ void passA_fwd_cplx(f32x2* X, const bf16x8v (&fr)[8], int tid) {
    const int lane = tid & 63, w = tid >> 6, n = lane & 31, hi = lane >> 5;
    bf16x8v A0[4], A1[4];
#pragma unroll
    for (int s_ = 0; s_ < 4; ++s_) { A0[s_] = fr[s_]; A1[s_] = fr[4 + s_]; }
#pragma unroll
    for (int nt = 0; nt < 2; ++nt) { const int a = 64 * w + 32 * nt + n;
        float xr0[8], xi0[8], xr1[8], xi1[8];
#pragma unroll
        for (int j = 0; j < 8; ++j) { const f32x2 p = X[phA(a, 8 * hi + j)], q = X[phA(a, 16 + 8 * hi + j)]; xr0[j] = p.x; xi0[j] = p.y; xr1[j] = q.x; xi1[j] = q.y; }
        const bf16x8v B0 = pack8(xr0), B1 = pack8(xr1), B2 = pack8(xi0), B3 = pack8(xi1);
        f32x16v c0 = {}, c1 = {};
        c0 = HYM_MFMA(A0[0], B0, c0); c1 = HYM_MFMA(A1[0], B0, c1); c0 = HYM_MFMA(A0[1], B1, c0); c1 = HYM_MFMA(A1[1], B1, c1);
        c0 = HYM_MFMA(A0[2], B2, c0); c1 = HYM_MFMA(A1[2], B2, c1); c0 = HYM_MFMA(A0[3], B3, c0); c1 = HYM_MFMA(A1[3], B3, c1);
        f32x2 lo4[4], hi4[4]; tw_rows(a, -1.f, hi, lo4, hi4);
#pragma unroll
        for (int r = 0; r < 16; ++r) { const f32x2 wv = cmul(lo4[r & 3], hi4[r >> 2]); X[phA(a, crow(r, hi))] = cmul((f32x2){c0[r], c1[r]}, wv); } }
}
__device__ __forceinline__ void passC_store(f32x2* X, const bf16x8v (&fr)[4], int tid) {
    const int lane = tid & 63, w = tid >> 6, n = lane & 31, hi = lane >> 5;
    const bf16x8v F0 = fr[0], F1 = fr[1];
#pragma unroll 2
    for (int nt = 0; nt < 4; ++nt) { const int g = 128 * w + 32 * nt + n;
        float xr[8], xi[8];
#pragma unroll
        for (int j = 0; j < 8; ++j) { const f32x2 p = X[phC(g, 8 * hi + j)]; xr[j] = p.x; xi[j] = p.y; }
        f32x16v c = {};
        c = HYM_MFMA(F0, pack8(xr), c); c = HYM_MFMA(F1, pack8(xi), c);
#pragma unroll
        for (int r = 0; r < 8; ++r) X[phC(g, crow(r, hi))] = (f32x2){c[r] * (1.0f / N), c[8 + r] * (1.0f / N)}; }
}
__device__ __forceinline__ void split_spectra(const f32x2* X, f32x2* __restrict__ K1, f32x2* __restrict__ K2, int tid) {
#pragma unroll 4
    for (int i = 0; i < 32; ++i) { const int p = tid + 512 * i, kb = p >> 9, kb2 = (p >> 4) & 31, ka = p & 15;
        const int b1 = kb != 0, kbp = (32 - kb) & 31, kb2p = (32 - kb2 - b1) & 31, b2 = (kb2 != 0) | b1, kap = (16 - ka - b2) & 15;
        const f32x2 fk = X[phC(p >> 4, ka)], fp = X[phC(32 * kbp + kb2p, kap)];
        K1[p] = (f32x2){0.5f * (fk.x + fp.x), 0.5f * (fk.y - fp.y)};
        K2[p] = (f32x2){0.5f * (fk.y + fp.y), -0.5f * (fk.x - fp.x)}; }
}
__device__ __forceinline__ void passA_inv_gate(const f32x2* X, const bf16x8v (&fr)[4], __amdgpu_buffer_rsrc_t R, unsigned ina, unsigned inb, unsigned ga, unsigned gb, unsigned oa, unsigned ob, float hb, int tid) {
    const int lane = tid & 63, w = tid >> 6, n = lane & 31, hi = lane >> 5;
    bf16x8v AH[4];
#pragma unroll
    for (int s_ = 0; s_ < 4; ++s_) AH[s_] = fr[s_];
#pragma unroll
    for (int nt = 0; nt < 2; ++nt) { const int a = 64 * w + 32 * nt + n;
        f32x2 lo8[8], hx[2]; tw_cols(a, 1.f, hi, lo8, hx);
        float xr0[8], xi0[8], xr1[8], xi1[8];
#pragma unroll
        for (int j = 0; j < 8; ++j) { const f32x2 p = cmul(X[phA(a, 8 * hi + j)], cmul(lo8[j], hx[0])), q = cmul(X[phA(a, 16 + 8 * hi + j)], cmul(lo8[j], hx[1]));
            xr0[j] = p.x; xi0[j] = p.y; xr1[j] = q.x; xi1[j] = q.y; }
        f32x16v c = {};
        c = HYM_MFMA(AH[0], pack8(xr0), c); c = HYM_MFMA(AH[1], pack8(xr1), c); c = HYM_MFMA(AH[2], pack8(xi0), c); c = HYM_MFMA(AH[3], pack8(xi1), c);
        const unsigned vo = 4u * (unsigned)a + 8192u * (unsigned)hi;
        float za[8], zb[8], gva[8], gvb[8];
#pragma unroll
        for (int r = 0; r < 8; ++r) { const unsigned so = 2048u * (unsigned)((r & 3) + 8 * (r >> 2));
            za[r] = bld_f32(R, vo, ina + so); zb[r] = bld_f32(R, vo, inb + so); gva[r] = bld_f32(R, vo, ga + so); gvb[r] = bld_f32(R, vo, gb + so); }
#pragma unroll
        for (int r = 0; r < 8; ++r) { const unsigned so = 2048u * (unsigned)((r & 3) + 8 * (r >> 2));
            bst_f32(R, vo, oa + so, gva[r] * (c[r] + za[r] * hb)); bst_f32(R, vo, ob + so, gvb[r] * (c[8 + r] + zb[r] * hb)); } }
}
__device__ __forceinline__ void passA_inv_gate_r(const f32x2* X, const bf16x8v (&fr)[4], __amdgpu_buffer_rsrc_t R, unsigned ina, unsigned inb, unsigned ga, unsigned gb, float hb, int tid, float (&zo)[2][16]) {
    const int lane = tid & 63, w = tid >> 6, n = lane & 31, hi = lane >> 5;
    bf16x8v AH[4];
#pragma unroll
    for (int s_ = 0; s_ < 4; ++s_) AH[s_] = fr[s_];
#pragma unroll
    for (int nt = 0; nt < 2; ++nt) { const int a = 64 * w + 32 * nt + n;
        const unsigned vo = 2u * (unsigned)a + 4096u * (unsigned)hi;
        float za[8], zb[8], gva[8], gvb[8];
#pragma unroll
        for (int r = 0; r < 8; ++r) { const unsigned so = 1024u * (unsigned)((r & 3) + 8 * (r >> 2));
            za[r] = bld_b16f(R, vo, ina + so); zb[r] = bld_b16f(R, vo, inb + so); gva[r] = bld_b16f(R, vo, ga + so); gvb[r] = bld_b16f(R, vo, gb + so); }
        f32x2 lo8[8], hx[2]; tw_cols(a, 1.f, hi, lo8, hx);
        float xr0[8], xi0[8], xr1[8], xi1[8];
#pragma unroll
        for (int j = 0; j < 8; ++j) { const f32x2 p = cmul(X[phA(a, 8 * hi + j)], cmul(lo8[j], hx[0])), q = cmul(X[phA(a, 16 + 8 * hi + j)], cmul(lo8[j], hx[1]));
            xr0[j] = p.x; xi0[j] = p.y; xr1[j] = q.x; xi1[j] = q.y; }
        f32x16v c = {};
        c = HYM_MFMA(AH[0], pack8(xr0), c); c = HYM_MFMA(AH[1], pack8(xr1), c); c = HYM_MFMA(AH[2], pack8(xi0), c); c = HYM_MFMA(AH[3], pack8(xi1), c);
#pragma unroll
        for (int r = 0; r < 8; ++r) { zo[nt][r] = gva[r] * (c[r] + za[r] * hb); zo[nt][8 + r] = gvb[r] * (c[8 + r] + zb[r] * hb); } }
}
__device__ __forceinline__ void passA_fwd_r(f32x2* X, const bf16x8v (&fr)[4], const float (&zi)[2][16], int tid) {
    const int lane = tid & 63, w = tid >> 6, n = lane & 31, hi = lane >> 5;
    const bf16x8v A0a = fr[0], A1a = fr[1], A0b = fr[2], A1b = fr[3];
#pragma unroll
    for (int nt = 0; nt < 2; ++nt) { const int a = 64 * w + 32 * nt + n;
        float u0[8], u1[8];
#pragma unroll
        for (int k = 0; k < 4; ++k) {
            { auto rr = __builtin_amdgcn_permlane32_swap(__float_as_uint(zi[nt][k]), __float_as_uint(zi[nt][4 + k]), false, false); u0[k] = __uint_as_float(rr[0]); u0[4 + k] = __uint_as_float(rr[1]); }
            { auto rr = __builtin_amdgcn_permlane32_swap(__float_as_uint(zi[nt][8 + k]), __float_as_uint(zi[nt][12 + k]), false, false); u1[k] = __uint_as_float(rr[0]); u1[4 + k] = __uint_as_float(rr[1]); } }
        const bf16x8v B0 = pack8(u0), B1 = pack8(u1);
        f32x16v c0 = {}, c1 = {};
        c0 = HYM_MFMA(A0a, B0, c0); c1 = HYM_MFMA(A1a, B0, c1); c0 = HYM_MFMA(A0b, B1, c0); c1 = HYM_MFMA(A1b, B1, c1);
        f32x2 lo4[4], hi4[4]; tw_rows(a, -1.f, hi, lo4, hi4);
#pragma unroll
        for (int r = 0; r < 16; ++r) { const f32x2 wv = cmul(lo4[r & 3], hi4[r >> 2]); X[phA(a, crow(r, hi))] = cmul((f32x2){c0[r], c1[r]}, wv); } }
}
__device__ __forceinline__ void passA_inv_gate_f(const f32x2* X, const bf16x8v (&fr)[4], __amdgpu_buffer_rsrc_t R, unsigned ga, unsigned gb, unsigned oa, unsigned ob, float hb, int tid, const float (&zi)[2][16]) {
    const int lane = tid & 63, w = tid >> 6, n = lane & 31, hi = lane >> 5;
    bf16x8v AH[4];
#pragma unroll
    for (int s_ = 0; s_ < 4; ++s_) AH[s_] = fr[s_];
    float gva[2][8], gvb[2][8];
#pragma unroll
    for (int nt = 0; nt < 2; ++nt) { const unsigned vo = 2u * (unsigned)(64 * w + 32 * nt + n) + 4096u * (unsigned)hi;
#pragma unroll
        for (int r = 0; r < 8; ++r) { const unsigned so = 1024u * (unsigned)((r & 3) + 8 * (r >> 2)); gva[nt][r] = bld_b16f(R, vo, ga + so); gvb[nt][r] = bld_b16f(R, vo, gb + so); } }
#pragma unroll
    for (int nt = 0; nt < 2; ++nt) { const int a = 64 * w + 32 * nt + n;
        f32x2 lo8[8], hx[2]; tw_cols(a, 1.f, hi, lo8, hx);
        float xr0[8], xi0[8], xr1[8], xi1[8];
#pragma unroll
        for (int j = 0; j < 8; ++j) { const f32x2 p = cmul(X[phA(a, 8 * hi + j)], cmul(lo8[j], hx[0])), q = cmul(X[phA(a, 16 + 8 * hi + j)], cmul(lo8[j], hx[1]));
            xr0[j] = p.x; xi0[j] = p.y; xr1[j] = q.x; xi1[j] = q.y; }
        f32x16v c = {};
        c = HYM_MFMA(AH[0], pack8(xr0), c); c = HYM_MFMA(AH[1], pack8(xr1), c); c = HYM_MFMA(AH[2], pack8(xi0), c); c = HYM_MFMA(AH[3], pack8(xi1), c);
        const unsigned vo = 4u * (unsigned)a + 8192u * (unsigned)hi;
#pragma unroll
        for (int r = 0; r < 8; ++r) { const unsigned so = 2048u * (unsigned)((r & 3) + 8 * (r >> 2));
            bst_f32(R, vo, oa + so, gva[nt][r] * (c[r] + zi[nt][r] * hb)); bst_f32(R, vo, ob + so, gvb[nt][r] * (c[8 + r] + zi[nt][8 + r] * hb)); } }
}
#undef HYM_MFMA
}
#define F_dft ((const bf16*)(F.ws + WS_DFT))
__device__ __forceinline__ void fill_dft_table(Frame& F) {
    for (int i = F.bid * NTHR + F.tid; i < hym::T_NFRAG * 64 * 8; i += PB * NTHR) ((bf16*)(F.ws + WS_DFT))[i] = (bf16)f2bf(hym::dft_entry(i >> 9, (i >> 3) & 63, i & 7));
}
__device__ __forceinline__ void hyena_mf_filters(Frame& F, int layer, int c) {
    f32x2* X = (f32x2*)F.ldsg; const bf16* tab = F_dft;
    f32x2* KF = F_kf + (size_t)F.bid * 2 * hym::N;
    const float mind = -4.605170185988091f / 1.5f, maxd = -4.605170185988091f / 0.3f;
    const float adelta = fabsf(mind + (float)c * ((maxd - mind) / 511.0f));
    const int tid = hyf::opq(F.tid);
    { typedef short bf16x8v __attribute__((ext_vector_type(8)));
      const int lane = tid & 63, wv = tid >> 6, fr = lane & 15, fq = lane >> 4;
      bf16x8v wf0 = {0, 0, 0, 0, 0, 0, 0, 0}, wf1 = {0, 0, 0, 0, 0, 0, 0, 0};
      if (fr < 4) { const int j = (fr >> 1) * 1024 + (fr & 1) * 512 + c; const float* wp = FIN(IN_FW3) + (size_t)layer * 64 * 2048 + j;
#pragma unroll
          for (int e = 0; e < 8; ++e) { wf0[e] = (short)f2bf(wp[(size_t)(8 * fq + e) * 2048]); wf1[e] = (short)f2bf(wp[(size_t)(32 + 8 * fq + e) * 2048]); } }
      const bf16* a2b = (const bf16*)(F.ws + WS_A2B) + (size_t)layer * SEQ * 64;
      const float b3a = FIN(IN_FB3)[layer * 2048 + c], b3b = FIN(IN_FB3)[layer * 2048 + 512 + c], b3c = FIN(IN_FB3)[layer * 2048 + 1024 + c], b3d = FIN(IN_FB3)[layer * 2048 + 1536 + c];
      __syncthreads();
      if (tid == 256) X[hyf::phA(0, 16)] = (f32x2){0.f, 0.f};
#pragma unroll 8
      for (int blk = wv; blk < SEQ / 16; blk += NWAVES) { const int m = 16 * blk + fr;
          const bf16x8v a0 = *(const bf16x8v*)(a2b + (size_t)m * 64 + 8 * fq), a1 = *(const bf16x8v*)(a2b + (size_t)m * 64 + 32 + 8 * fq);
          f32x4 acc = (f32x4){0.f, 0.f, 0.f, 0.f};
          acc = __builtin_amdgcn_mfma_f32_16x16x32_bf16(wf0, a0, acc, 0, 0, 0); acc = __builtin_amdgcn_mfma_f32_16x16x32_bf16(wf1, a1, acc, 0, 0, 0);
          if (fq == 0) { const float dec = __expf(-((float)m / (float)(SEQ - 1)) * adelta);
              X[hyf::phA(m & 511, m >> 9)] = (f32x2){(acc.x + b3a) * dec, (acc.z + b3c) * dec};
              if (m >= 1) { const int p = hym::N - m; X[hyf::phA(p & 511, p >> 9)] = (f32x2){(acc.y + b3b) * dec, (acc.w + b3d) * dec}; } } } }
    { const int ln = hyf::opq(tid) & 63; hym::bf16x8v f8[8], f4[4];
      hym::ld_F32F(f8, tab, ln);
      __syncthreads();
      hym::passA_fwd_cplx(X, f8, hyf::opq(tid));
      hym::ld_C(f4, tab, ln);
      __syncthreads();
      hym::passB_fwd(X, f8, hyf::opq(tid));
      __syncthreads();
      hym::passC_store(X, f4, hyf::opq(tid)); }
    __syncthreads();
    hym::split_spectra(X, KF, KF + hym::N, hyf::opq(tid));
    asm volatile("s_waitcnt vmcnt(0)" ::: "memory");
    __syncthreads();
}
__device__ __forceinline__ void hyena_mf_data(Frame& F, int layer, int c) {
    f32x2* X = (f32x2*)F.ldsg; const bf16* tab = F_dft;
    f32x2* KF = F_kf + (size_t)F.bid * 2 * hym::N;
    const float* cw = FIN(IN_HCW) + layer * 3 * HYP; const float* cb = FIN(IN_HCB) + layer * HYP;
    const int tid = hyf::opq(F.tid); const unsigned v4 = 4u * (unsigned)tid, v2 = 2u * (unsigned)tid;
    const __amdgpu_buffer_rsrc_t R = __builtin_amdgcn_make_buffer_rsrc((void*)F.ws, 0, (unsigned)WS_END, 0x00020000);
    const unsigned Sb = (unsigned)(WS_HS + (size_t)launder_u((unsigned)F.bid) * 6 * SEQ * 4);
    const float hb0 = FIN(IN_HBIAS)[layer * 1024 + c], hb1 = FIN(IN_HBIAS)[layer * 1024 + 512 + c];
#pragma unroll 1
    for (int pr = 0; pr < 2; ++pr) {
        const unsigned oab = (unsigned)(WS_ZT + ((size_t)c * MTOT + (size_t)(2 * pr) * SEQ) * 4), obb = oab + SEQ * 4;
        { typedef unsigned v4u_a4 __attribute__((ext_vector_type(4), aligned(4)));
          v4u wq[6][4]; float cwv[3][4];
#pragma unroll
          for (int j = 0; j < 3; ++j) { const int ch = j * HYW + c; cwv[j][0] = cw[ch]; cwv[j][1] = cw[HYP + ch]; cwv[j][2] = cw[2 * HYP + ch]; cwv[j][3] = cb[ch]; }
#pragma unroll
          for (int r6 = 0; r6 < 6; ++r6) { const int ch = (r6 >> 1) * HYW + c; const bf16* up = F_hyT + (size_t)ch * MTOT + (size_t)(2 * pr + (r6 & 1)) * SEQ + 4 * tid - 2;
#pragma unroll
              for (int k = 0; k < 4; ++k) { const v4u_a4 t_ = *(const v4u_a4*)(up + 2048 * k); wq[r6][k] = (v4u){t_.x, t_.y, t_.z, t_.w}; } }
#pragma unroll
          for (int r6 = 0; r6 < 6; ++r6) { bf16* sp = (bf16*)(F.ws + WS_HS + (size_t)launder_u((unsigned)F.bid) * 6 * SEQ * 4) + (size_t)r6 * SEQ + 4 * tid;
              const float w0 = cwv[r6 >> 1][0], w1 = cwv[r6 >> 1][1], w2 = cwv[r6 >> 1][2], bb = cwv[r6 >> 1][3];
#pragma unroll
              for (int k = 0; k < 4; ++k) { const v4u p = wq[r6][k];
                  float u1 = __uint_as_float(p.x & 0xffff0000u), u6 = __uint_as_float(p.w << 16);
                  if (k == 0 && tid == 0) u1 = 0.f;
                  if (k == 3 && tid == 511) u6 = 0.f;
                  const float u2 = __uint_as_float(p.y << 16), u3 = __uint_as_float(p.y & 0xffff0000u), u4 = __uint_as_float(p.z << 16), u5 = __uint_as_float(p.z & 0xffff0000u);
                  *(v2u*)(sp + 2048 * k) = (v2u){pk2(w0 * u1 + w1 * u2 + w2 * u3 + bb, w0 * u2 + w1 * u3 + w2 * u4 + bb), pk2(w0 * u3 + w1 * u4 + w2 * u5 + bb, w0 * u4 + w1 * u5 + w2 * u6 + bb)}; } } }
        asm volatile("s_waitcnt vmcnt(0)" ::: "memory"); __syncthreads();
        float zr[2][16];
#pragma unroll
        for (int i = 0; i < 16; ++i) { zr[0][i] = 0.f; zr[1][i] = 0.f; }
#pragma unroll 1
        for (int o = 0; o < 2; ++o) {
            const unsigned ga = Sb + (unsigned)((2 + 2 * o) * SEQ * 2), gb = ga + SEQ * 2;
            const float hb = o == 0 ? hb0 : hb1;
            { const int ln = hyf::opq(tid) & 63; hym::bf16x8v f8[8], f4[4];
              hym::ld_A(f4, tab, ln, false);
              if (o == 0) hym::passA_fwd<false>(X, f4, R, Sb, Sb + SEQ * 2, hyf::opq(tid)); else hym::passA_fwd_r(X, f4, zr, hyf::opq(tid));
              hym::ld_F32F(f8, tab, ln);
              __syncthreads();
              hym::passB_fwd(X, f8, hyf::opq(tid));
              hym::ld_C(f4, tab, ln);
              __syncthreads();
              hym::passC<true>(X, f4, KF + (size_t)o * hym::N, hyf::opq(tid));
              hym::ld_F32I(f8, tab, ln);
              __syncthreads();
              hym::passB_inv(X, f8, hyf::opq(tid));
              hym::ld_AH(f4, tab, ln);
              __syncthreads();
              if (o == 0) hym::passA_inv_gate_r(X, f4, R, Sb, Sb + SEQ * 2, ga, gb, hb, hyf::opq(tid), zr); else hym::passA_inv_gate_f(X, f4, R, ga, gb, oab, obb, hb, hyf::opq(tid), zr); }
            if (o == 0) __syncthreads();
        }
        __syncthreads();
    }
}
__device__ __forceinline__ void hyena_ctx_unit(Frame& F, int layer, int c) {
    constexpr int L = CTXL;
    float* H = (float*)F.ldsg;
    float* zb = H + 2 * (2 * L + 32);
    float* zn = zb + 4 * L;
    float* w3s = zn + 4 * L;
    const float* a2 = F_a2c;
    const float* cw = FIN(IN_HCW) + layer * 3 * HYP; const float* cb = FIN(IN_HCB) + layer * HYP;
    const float mind = -4.605170185988091f / 1.5f, maxd = -4.605170185988091f / 0.3f;
    const float adelta = fabsf(mind + (float)c * ((maxd - mind) / 511.0f));
    const int tid = F.tid;
    __syncthreads();
    if (tid < 256) { const int col = tid >> 6, k = tid & 63, j = (col >> 1) * 1024 + (col & 1) * 512 + c; w3s[tid] = FIN(IN_FW3)[((size_t)layer * 64 + k) * 2048 + j]; }
    if (tid < 64) { const int o = tid >> 5, i = tid & 31; float* Ho = H + o * (2 * L + 32); if (i < 16) Ho[i] = 0.f; else Ho[2 * L + i] = 0.f; }
    if (tid >= 64 && tid < 66) H[(tid - 64) * (2 * L + 32) + 2 * L + 15] = 0.f;
    { const float w0 = cw[c], w1 = cw[HYP + c], w2 = cw[2 * HYP + c], bb = cb[c];
#pragma unroll
      for (int q = 0; q < 2; ++q) { const int e = tid + 512 * q, b = e >> 8, t = e & 255; zb[e] = hy_short(F_hyT + (size_t)c * MTOT + NLAT + b * L, t, L, w0, w1, w2, bb); } }
    __syncthreads();
    { const int m = tid & 255, o = tid >> 8; float sf = 0.f, sb = 0.f; const float* wf = w3s + (2 * o) * 64; const float* wb = wf + 64;
#pragma unroll 16
      for (int k = 0; k < 64; ++k) { const float a = a2[(size_t)k * L + m]; sf += a * wf[k]; sb += a * wb[k]; }
      const float dec = __expf(-((float)m / (float)(L - 1)) * adelta); float* Ho = H + o * (2 * L + 32);
      Ho[L + 15 + m] = (sf + FIN(IN_FB3)[layer * 2048 + o * 1024 + c]) * dec; if (m >= 1) Ho[L + 15 - m] = (sb + FIN(IN_FB3)[layer * 2048 + o * 1024 + 512 + c]) * dec; }
    __syncthreads();
#pragma unroll
    for (int o = 0; o < 2; ++o) {
        const float* zin = o == 0 ? zb : zn; float* zout = o == 0 ? zn : zb; const float* Ho = H + o * (2 * L + 32);
        const int ch = (o + 1) * HYW + c; const float w0 = cw[ch], w1 = cw[HYP + ch], w2 = cw[2 * HYP + ch], bb = cb[ch], hb = FIN(IN_HBIAS)[layer * 1024 + o * 512 + c];
#pragma unroll
        for (int q = 0; q < 2; ++q) { const int e = tid + 512 * q, b = e >> 8, t = e & 255; float a = 0.f; const float* zi = zin + b * L;
#pragma unroll 8
            for (int sidx = 0; sidx < L; ++sidx) a += zi[sidx] * Ho[t - sidx + L + 15];
            const float xo = hy_short(F_hyT + (size_t)ch * MTOT + NLAT + b * L, t, L, w0, w1, w2, bb); const float zv = xo * (a + zi[t] * hb);
            if (o == 0) zout[e] = zv; else F_zT[(size_t)c * MTOT + NLAT + b * L + t] = zv; }
        __syncthreads();
    }
}
__device__ __forceinline__ void mixa_hyena(Frame& F, int layer) {
    for (int u = F.bid; u < HYW; u += F.G) { hyena_mf_filters(F, layer, u); hyena_mf_data(F, layer, u); }
}
__device__ __forceinline__ void mixa_ctx(Frame& F, int layer) {
    if (layer != 0) return;
    for (int u = F.bid; u < HYW; u += F.G) hyena_ctx_unit(F, layer, u);
}
__device__ __forceinline__ void mixa_pool(Frame& F, int layer) {
    const int ntile = (layer == 0 ? MTOT : NLAT) / 128, npool = ntile * 4;
    for (int u = F.bid; u < npool; u += F.G) pool_unit(F, layer, u >> 2, u & 3);
}

__device__ __forceinline__ float dot128(const float* qs, const bf16* krow) {
    float s = 0.f;
#pragma unroll
    for (int c = 0; c < 16; ++c) { const v4u kv = *(const v4u*)(krow + 8 * c); const f32x4 q0 = *(const f32x4*)(qs + 8 * c), q1 = *(const f32x4*)(qs + 8 * c + 4);
        s += q0.x * __uint_as_float(kv.x << 16) + q0.y * __uint_as_float(kv.x & 0xffff0000u) + q0.z * __uint_as_float(kv.y << 16) + q0.w * __uint_as_float(kv.y & 0xffff0000u)
           + q1.x * __uint_as_float(kv.z << 16) + q1.y * __uint_as_float(kv.z & 0xffff0000u) + q1.z * __uint_as_float(kv.w << 16) + q1.w * __uint_as_float(kv.w & 0xffff0000u); }
    return s;
}
__device__ __forceinline__ void attn_phase_simple(Frame& F, int layer, int row_lo) {
    const int nrows = layer == 0 ? MTOT : NLAT;
    float* qs = (float*)F.ldsg + F.wave * 768; float* ps = qs + 128;
    const int h = F.wave, kvh = h >> 2; const float sink = FIN(IN_SINK)[layer * 8 + h];
    __syncthreads();
    for (int row = row_lo + F.bid; row < nrows; row += F.G) {
        const bool cx = row >= NLAT; const int b = cx ? (row - NLAT) >> 8 : row >> 13;
        { const bf16* qp = F_proj + (size_t)row * QKVP + h * 128; qs[F.lane] = bf2f(qp[F.lane]); qs[64 + F.lane] = bf2f(qp[64 + F.lane]); }
        LDS_WAIT(); asm volatile("" ::: "memory");
        const bf16* kc = F_proj + (size_t)(NLAT + b * CTXL) * QKVP + 1024 + kvh * 128;
        float mx = sink;
        int nblk = 0, qi = 0;
        if (!cx) { const int t = row & (SEQ - 1); nblk = t >> 7; qi = t & 127; }
#pragma unroll 1
        for (int j = 0; j < 6; ++j) { float sc = -1e30f;
            if (!cx) { const int ki = F.lane + 64 * j, kpos = 128 * (nblk - 1) + ki;
                if (kpos >= 0 && kpos < SEQ && ki >= qi && ki <= qi + 256) sc = dot128(qs, F_proj + (size_t)(b * SEQ + kpos) * QKVP + 1024 + kvh * 128); }
            ps[F.lane + 64 * j] = sc; mx = fmaxf(mx, sc); }
#pragma unroll 1
        for (int j = 0; j < 4; ++j) { const float sc = dot128(qs, kc + (size_t)(F.lane + 64 * j) * QKVP); ps[384 + F.lane + 64 * j] = sc; mx = fmaxf(mx, sc); }
        mx = wave_max(mx);
        float den = 0.f;
#pragma unroll 1
        for (int j = 0; j < 10; ++j) { const float sc = ps[F.lane + 64 * j]; const float p = sc > -1e29f ? __expf(sc - mx) : 0.f; ps[F.lane + 64 * j] = p; den += p; }
        den = wave_sum(den) + __expf(sink - mx);
        LDS_WAIT(); asm volatile("" ::: "memory");
        float o0 = 0.f, o1 = 0.f;
        if (!cx) { const int klo = qi, khi = qi + 256;
#pragma unroll 4
            for (int ki = klo; ki <= khi; ++ki) { const int kpos = 128 * (nblk - 1) + ki; if (kpos < 0 || kpos >= SEQ) continue; const float p = ps[ki];
                const unsigned vv = *(const unsigned*)(F_proj + (size_t)(b * SEQ + kpos) * QKVP + 1280 + kvh * 128 + 2 * F.lane); o0 += p * __uint_as_float(vv << 16); o1 += p * __uint_as_float(vv & 0xffff0000u); } }
        { const bf16* vc = F_proj + (size_t)(NLAT + b * CTXL) * QKVP + 1280 + kvh * 128 + 2 * F.lane;
#pragma unroll 4
          for (int k = 0; k < CTXL; ++k) { const float p = ps[384 + k]; const unsigned vv = *(const unsigned*)(vc + (size_t)k * QKVP); o0 += p * __uint_as_float(vv << 16); o1 += p * __uint_as_float(vv & 0xffff0000u); } }
        const float inv = 1.0f / den;
        *(f32x2*)(F_att + (size_t)row * ATTW + h * 128 + 2 * F.lane) = (f32x2){o0 * inv, o1 * inv};
        asm volatile("" ::: "memory");
    }
}

namespace att2 {
typedef short bf16x8 __attribute__((ext_vector_type(8)));
typedef short s16x4 __attribute__((ext_vector_type(4)));
typedef float f32x16 __attribute__((ext_vector_type(16)));
typedef unsigned u32x4 __attribute__((ext_vector_type(4)));
constexpr int D = 128, QBLK = 32, KVBLK = 64, LDK = QKVP, LDO = ATTW;
constexpr float THR = 8.f, C = 1.4426950408889634f;
constexpr int SHM_V = KVBLK * D * 2, SHM_K = KVBLK * D * 2;
#define KSWZ(row, colB) ((row) * 256 + ((colB) ^ (((row) & 7) << 4)))
#define SBAR() __builtin_amdgcn_sched_barrier(0)
__device__ __forceinline__ int crow(int r, int hi) { return (r & 3) + 8 * (r >> 2) + 4 * hi; }
__device__ __forceinline__ unsigned cvtpk(float lo, float hi) { unsigned r; asm volatile("v_cvt_pk_bf16_f32 %0, %1, %2" : "=v"(r) : "v"(lo), "v"(hi)); return r; }
__device__ __forceinline__ void partialSM(f32x16& p0, f32x16& p1, float& m_reg, float& mn, float& alpha) {
  float pmax = p0[0]; for (int r = 1; r < 16; ++r) pmax = fmaxf(pmax, p0[r]); for (int r = 0; r < 16; ++r) pmax = fmaxf(pmax, p1[r]);
  { auto rr = __builtin_amdgcn_permlane32_swap(__float_as_uint(pmax), __float_as_uint(pmax), false, false);
    pmax = fmaxf(__uint_as_float(rr[0]), __uint_as_float(rr[1])); }
  if (__builtin_expect(__all(pmax - m_reg <= THR), 1)) { mn = m_reg; alpha = 1.f; }
  else { mn = fmaxf(m_reg, pmax); alpha = __builtin_amdgcn_exp2f((m_reg - mn) * C); m_reg = mn; }
  float mnC = -mn * C;
  for (int r = 0; r < 16; ++r) p0[r] = fmaf(p0[r], C, mnC); for (int r = 0; r < 16; ++r) p1[r] = fmaf(p1[r], C, mnC);
  for (int r = 0; r < 16; ++r) p0[r] = __builtin_amdgcn_exp2f(p0[r]);
}
__device__ __forceinline__ void finishSM(f32x16& p0, f32x16& p1, float alpha, float& l_reg, bf16x8& pa0, bf16x8& pa1, bf16x8& pa2, bf16x8& pa3) {
  for (int r = 0; r < 16; ++r) p1[r] = __builtin_amdgcn_exp2f(p1[r]);
  float ps = 0; for (int r = 0; r < 16; ++r) ps += p0[r]; for (int r = 0; r < 16; ++r) ps += p1[r];
  { auto rr = __builtin_amdgcn_permlane32_swap(__float_as_uint(ps), __float_as_uint(ps), false, false);
    ps = __uint_as_float(rr[0]) + __uint_as_float(rr[1]); }
  l_reg = l_reg * alpha + ps;
#define PK4(P, BASE, OUT) do { unsigned a0 = cvtpk(P[BASE + 0], P[BASE + 1]), a1 = cvtpk(P[BASE + 2], P[BASE + 3]);   \
    unsigned b0 = cvtpk(P[BASE + 4], P[BASE + 5]), b1 = cvtpk(P[BASE + 6], P[BASE + 7]);                              \
    auto r0 = __builtin_amdgcn_permlane32_swap(a0, b0, false, false); auto r1 = __builtin_amdgcn_permlane32_swap(a1, b1, false, false); \
    u32x4 w = {r0[0], r1[0], r0[1], r1[1]}; OUT = *reinterpret_cast<bf16x8*>(&w); } while (0)
  PK4(p0, 0, pa0); PK4(p0, 8, pa1); PK4(p1, 0, pa2); PK4(p1, 8, pa3);
#undef PK4
}
__device__ __forceinline__ void qkt(f32x16& p0, f32x16& p1, const char* Ks, const char* qs, int r32, int hi) {
  p0 = f32x16{}; p1 = f32x16{};
  for (int d0 = 0; d0 < 8; ++d0) { int cb = (d0 * 16 + hi * 8) * 2;
    bf16x8 b0 = *reinterpret_cast<const bf16x8*>(Ks + KSWZ(r32, cb));
    bf16x8 b1 = *reinterpret_cast<const bf16x8*>(Ks + KSWZ(32 + r32, cb));
    bf16x8 q = *reinterpret_cast<const bf16x8*>(qs + d0 * 1024);
    p0 = __builtin_amdgcn_mfma_f32_32x32x16_bf16(b0, q, p0, 0, 0, 0);
    p1 = __builtin_amdgcn_mfma_f32_32x32x16_bf16(b1, q, p1, 0, 0, 0); }
}
__device__ __forceinline__ void mask_tile(f32x16& p0, f32x16& p1, int kb, int qi, int hi) {
#pragma unroll
  for (int r = 0; r < 16; ++r) { const int k0 = kb + crow(r, hi), k1 = k0 + 32;
    if (k0 < qi || k0 > qi + 256) p0[r] = -1e30f; if (k1 < qi || k1 > qi + 256) p1[r] = -1e30f; }
}
__device__ __forceinline__ int v_st(int k, int c) { const int kk = (k & ~0xC) | ((k & 4) << 1) | ((k & 8) >> 1); return ((kk >> 3) * 4 + (c >> 5)) * 512 + ((kk & 7) * 32 + (c & 31)) * 2; }
__device__ __forceinline__ int v_rd_base(int lane) { return ((lane & 3) << 3) | (((lane >> 2) & 3) << 6) | (((lane >> 4) & 1) << 5) | (((lane >> 5) & 1) << 8); }
constexpr int v_rd_off(int d0, int ks, int half) { return d0 * 512 + ks * 4096 + half * 2048; }
template <int OFF> __device__ __forceinline__ s16x4 tr_read(int vb) {
  s16x4 r; asm volatile("ds_read_b64_tr_b16 %0, %1 offset:%2" : "=&v"(r) : "v"(vb), "i"(OFF) : "memory"); return r;
}
template <int D0> __device__ __forceinline__ void pv_one(f32x16& od, int vb, bf16x8 pa0, bf16x8 pa1, bf16x8 pa2, bf16x8 pa3) {
  const s16x4 l0 = tr_read<v_rd_off(D0, 0, 0)>(vb), h0 = tr_read<v_rd_off(D0, 0, 1)>(vb), l1 = tr_read<v_rd_off(D0, 1, 0)>(vb), h1 = tr_read<v_rd_off(D0, 1, 1)>(vb);
  const s16x4 l2 = tr_read<v_rd_off(D0, 2, 0)>(vb), h2 = tr_read<v_rd_off(D0, 2, 1)>(vb), l3 = tr_read<v_rd_off(D0, 3, 0)>(vb), h3 = tr_read<v_rd_off(D0, 3, 1)>(vb);
  asm volatile("s_waitcnt lgkmcnt(0)" ::: "memory"); SBAR();
#define PK(L, H) (bf16x8){L[0], L[1], L[2], L[3], H[0], H[1], H[2], H[3]}
  od = __builtin_amdgcn_mfma_f32_32x32x16_bf16(pa0, PK(l0, h0), od, 0, 0, 0);
  od = __builtin_amdgcn_mfma_f32_32x32x16_bf16(pa1, PK(l1, h1), od, 0, 0, 0);
  od = __builtin_amdgcn_mfma_f32_32x32x16_bf16(pa2, PK(l2, h2), od, 0, 0, 0);
  od = __builtin_amdgcn_mfma_f32_32x32x16_bf16(pa3, PK(l3, h3), od, 0, 0, 0);
#undef PK
}
__device__ __forceinline__ void pv_d0(f32x16* o, int vb, bf16x8 pa0, bf16x8 pa1, bf16x8 pa2, bf16x8 pa3) {
  pv_one<0>(o[0], vb, pa0, pa1, pa2, pa3); pv_one<1>(o[1], vb, pa0, pa1, pa2, pa3); pv_one<2>(o[2], vb, pa0, pa1, pa2, pa3); pv_one<3>(o[3], vb, pa0, pa1, pa2, pa3);
}
__device__ __forceinline__ void attn_unit(const bf16* __restrict__ proj, float* __restrict__ att, const float* __restrict__ sinks, int b, int n, int hk, int hp, bool ctxq, char* lds, int ldsoff, int tid) {
  const int wid = tid >> 6, lane = tid & 63, r32 = lane & 31, hi = lane >> 5;
  char* V_lds = lds; char* K_lds = lds + 2 * SHM_V;
  float* ws = (float*)(lds + 2 * SHM_V + 2 * SHM_K) + wid * 64; float* li_l = ws; float* al_l = ws + 32;
  const int h = 4 * hk + 2 * hp + (wid >> 2), q0 = 32 * (wid & 3), qi = q0 + r32;
  const int qrow0 = ctxq ? NLAT + b * CTXL + 128 * n + q0 : b * SEQ + 128 * n + q0;
  float m_reg = -1e30f, l_reg = 0; f32x16 o[4] = {};
  char* qr = lds + 2 * SHM_V + 2 * SHM_K + 2048 + wid * 8192 + lane * 16;
  { const bf16* Qw = proj + (size_t)(qrow0 + r32) * LDK + h * D + hi * 8;
#pragma unroll
    for (int d0 = 0; d0 < 8; ++d0) *reinterpret_cast<bf16x8*>(qr + d0 * 1024) = *reinterpret_cast<const bf16x8*>(Qw + d0 * 16); }
  const int sr = tid >> 4, sc = (tid & 15) * 8, vst0 = v_st(sr, sc), vst1 = v_st(32 + sr, sc);
  const int vb0 = ldsoff + v_rd_base(lane);
  const int lskip = (n == 0) ? 2 : 0, NT = ctxq ? 4 : 4 + 6 - ((n == 0) ? 2 : 0) - ((n == SEQ / 128 - 1) ? 2 : 0);
  const bf16* Kb = proj + 1024 + hk * D + sc; const bf16* Vb = proj + 1280 + hk * D + sc;
#define TROW(T) ((T) < 4 ? (NLAT + b * CTXL + 64 * (T)) : (b * SEQ + 128 * (n - 1) + 64 * ((T) - 4 + lskip)))
#define TKB(T) ((T) < 4 ? -1 : 64 * ((T) - 4 + lskip))
  struct { bf16x8 vs0, vs1, ks0, ks1; } sr_[2];
#define SLOAD(i, T) do { const size_t _r = (size_t)(TROW(T) + sr) * LDK; sr_[i].vs0 = *reinterpret_cast<const bf16x8*>(Vb + _r); sr_[i].vs1 = *reinterpret_cast<const bf16x8*>(Vb + _r + 32 * LDK); \
    sr_[i].ks0 = *reinterpret_cast<const bf16x8*>(Kb + _r); sr_[i].ks1 = *reinterpret_cast<const bf16x8*>(Kb + _r + 32 * LDK); } while (0)
#define SWRITE(bb, i) do { *(bf16x8*)(V_lds + (bb) * SHM_V + vst0) = sr_[i].vs0;          \
    *(bf16x8*)(V_lds + (bb) * SHM_V + vst1) = sr_[i].vs1; int kc = sc * 2;               \
    *(bf16x8*)(K_lds + (bb) * SHM_K + KSWZ(sr, kc)) = sr_[i].ks0;                       \
    *(bf16x8*)(K_lds + (bb) * SHM_K + KSWZ(32 + sr, kc)) = sr_[i].ks1; } while (0)
#define SWAIT() asm volatile("s_waitcnt vmcnt(4)" ::: "memory")
#define RESC(a) do { if (__any((a) < 1.f)) { if (hi == 0) al_l[r32] = (a); asm volatile("s_waitcnt lgkmcnt(0)" ::: "memory"); \
    for (int d = 0; d < 4; ++d) for (int r = 0; r < 16; ++r) o[d][r] *= al_l[crow(r, hi)]; } } while (0)
#define MASK(P0, P1, T) do { const int _kb = TKB(T); if (_kb >= 0 && !(_kb >= q0 + 31 && _kb + 63 <= q0 + 256)) mask_tile(P0, P1, _kb, qi, hi); } while (0)
  f32x16 pA0, pA1, pB0, pB1; float mnA, mnB, alA, alB; bf16x8 pa0, pa1, pa2, pa3;
  constexpr int SE = 0, SO = 1;
  SLOAD(SE, 0); asm volatile("s_waitcnt vmcnt(0)" ::: "memory"); SWRITE(0, SE); __syncthreads();
  qkt(pA0, pA1, K_lds, qr, r32, hi); partialSM(pA0, pA1, m_reg, mnA, alA);
  SLOAD(SO, 1); SLOAD(SE, 2);
  SWAIT(); SWRITE(1, SO); __syncthreads();
  for (int j = 1; j + 1 < NT; j += 2) {
    SBAR(); qkt(pB0, pB1, K_lds + SHM_K, qr, r32, hi); MASK(pB0, pB1, j);
    finishSM(pA0, pA1, alA, l_reg, pa0, pa1, pa2, pa3); SBAR();
    SLOAD(SO, j + 2); SBAR();
    pv_d0(o, vb0, pa0, pa1, pa2, pa3); partialSM(pB0, pB1, m_reg, mnB, alB);
    __syncthreads(); SWAIT(); SWRITE(0, SE);
    RESC(alB); __syncthreads();
    SBAR(); qkt(pA0, pA1, K_lds, qr, r32, hi); MASK(pA0, pA1, j + 1);
    finishSM(pB0, pB1, alB, l_reg, pa0, pa1, pa2, pa3); SBAR();
    if (j + 3 < NT) SLOAD(SE, j + 3); SBAR();
    pv_d0(o, vb0 + SHM_V, pa0, pa1, pa2, pa3); partialSM(pA0, pA1, m_reg, mnA, alA);
    __syncthreads(); SWAIT(); SWRITE(1, SO);
    RESC(alA); __syncthreads();
  }
  SBAR(); qkt(pB0, pB1, K_lds + SHM_K, qr, r32, hi); MASK(pB0, pB1, NT - 1);
  finishSM(pA0, pA1, alA, l_reg, pa0, pa1, pa2, pa3); SBAR();
  pv_d0(o, vb0, pa0, pa1, pa2, pa3); partialSM(pB0, pB1, m_reg, mnB, alB);
  __syncthreads(); RESC(alB);
  finishSM(pB0, pB1, alB, l_reg, pa0, pa1, pa2, pa3); SBAR();
  pv_d0(o, vb0 + SHM_V, pa0, pa1, pa2, pa3);
  l_reg += __builtin_amdgcn_exp2f((sinks[h] - m_reg) * C);
  if (hi == 0) li_l[r32] = l_reg; asm volatile("s_waitcnt lgkmcnt(0)" ::: "memory");
  float rli[16];
#pragma unroll
  for (int r = 0; r < 16; ++r) rli[r] = __builtin_amdgcn_rcpf(li_l[crow(r, hi)]);
  float* Ow = att + (size_t)qrow0 * LDO + h * D;
#pragma unroll
  for (int r = 0; r < 16; ++r) { int orow = crow(r, hi);
    for (int d0 = 0; d0 < 4; ++d0) Ow[(size_t)orow * LDO + d0 * 32 + r32] = o[d0][r] * rli[r]; }
  __syncthreads();
#undef SLOAD
#undef SWRITE
#undef SWAIT
#undef RESC
#undef MASK
#undef TROW
#undef TKB
}
#undef KSWZ
#undef SBAR
}
__device__ __forceinline__ void attn_phase_mfma(Frame& F, int layer) {
    constexpr int NUL = NBATCH * (SEQ / 128) * 4, NUC = NBATCH * 2 * 4;
    const int NU = NUL + (layer == 0 ? NUC : 0);
    const float* sinks = FIN(IN_SINK) + layer * 8;
    __syncthreads();
    for (int u = F.bid; u < NU; u += F.G) {
        if (u < NUL) { const int bn = u % (NBATCH * (SEQ / 128)), hh = u / (NBATCH * (SEQ / 128));
            att2::attn_unit(F_proj, F_att, sinks, bn / (SEQ / 128), bn % (SEQ / 128), hh >> 1, hh & 1, false, (char*)F.ldsg, (int)(uintptr_t)F.lds, F.tid); }
        else { const int v = u - NUL, bn = v & 7, hh = v >> 3; att2::attn_unit(F_proj, F_att, sinks, bn >> 1, bn & 1, hh >> 1, hh & 1, true, (char*)F.ldsg, (int)(uintptr_t)F.lds, F.tid); }
    }
}

__device__ __forceinline__ void merge_phase(Frame& F, int layer) {
    const int ntile = (layer == 0 ? MTOT : NLAT) / 64; bf16* y = uni_h(F);
    float* zl = (float*)F.ldsg;
    const float* ga = FIN(IN_GATT) + layer * ATTW; const float* gp = FIN(IN_GPOOL) + layer * POOLW; const float* gh = FIN(IN_GHY) + layer * HYW;
    f32x4 gav[4], gpv[2]; float ghv[8];
#pragma unroll
    for (int k = 0; k < 4; ++k) gav[k] = *(const f32x4*)(ga + 256 * k + 4 * F.lane);
#pragma unroll
    for (int k = 0; k < 2; ++k) gpv[k] = *(const f32x4*)(gp + 256 * k + 4 * F.lane);
#pragma unroll
    for (int k = 0; k < 8; ++k) ghv[k] = gh[F.lane + 64 * k];
    for (int tile = F.bid; tile < ntile; tile += F.G) {
        const int row0 = tile * 64;
        __syncthreads();
        { const int tok = F.tid & 63;
#pragma unroll 16
          for (int i = 0; i < HYW / 8; ++i) { const int c = (F.tid >> 6) + 8 * i; zl[c * 65 + tok] = F_zT[(size_t)c * MTOT + row0 + tok]; } }
        __syncthreads();
#pragma unroll 1
        for (int hq = 0; hq < 2; ++hq) {
            f32x4 av[4][4], pv[4][2];
#pragma unroll
            for (int q = 0; q < 4; ++q) { const int row = row0 + F.wave * 8 + hq * 4 + q; const float* ar = F_att + (size_t)row * ATTW; const float* pr = F_pool + (size_t)row * POOLW;
#pragma unroll
                for (int k = 0; k < 4; ++k) av[q][k] = *(const f32x4*)(ar + 256 * k + 4 * F.lane);
#pragma unroll
                for (int k = 0; k < 2; ++k) pv[q][k] = *(const f32x4*)(pr + 256 * k + 4 * F.lane); }
#pragma unroll
            for (int q = 0; q < 4; ++q) { const int tok = F.wave * 8 + hq * 4 + q, row = row0 + tok;
                { float v[8]; float ss = 0.f;
#pragma unroll
                  for (int k = 0; k < 8; ++k) { v[k] = zl[(F.lane + 64 * k) * 65 + tok]; ss += v[k] * v[k]; }
                  const float rs = rsqrtf(wave_sum(ss) * (1.0f / HYW) + EPS);
#pragma unroll
                  for (int k = 0; k < 8; ++k) { const int c = F.lane + 64 * k; y[(size_t)row * DM + 1536 + c] = (bf16)f2bf(v[k] * rs * ghv[k]); } }
                { float ss = 0.f;
#pragma unroll
                  for (int k = 0; k < 4; ++k) { const f32x4 v = av[q][k]; ss += (v.x * v.x + v.y * v.y) + (v.z * v.z + v.w * v.w); }
                  const float rs = rsqrtf(wave_sum(ss) * (1.0f / ATTW) + EPS);
#pragma unroll
                  for (int k = 0; k < 4; ++k) { const int c = 256 * k + 4 * F.lane; const f32x4 o = av[q][k] * rs * gav[k];
                      v2u w; w.x = pk2(o.x, o.y); w.y = pk2(o.z, o.w); *(v2u*)(y + (size_t)row * DM + c) = w; } }
                { float ss = 0.f;
#pragma unroll
                  for (int k = 0; k < 2; ++k) { const f32x4 v = pv[q][k]; ss += (v.x * v.x + v.y * v.y) + (v.z * v.z + v.w * v.w); }
                  const float rs = rsqrtf(wave_sum(ss) * (1.0f / POOLW) + EPS);
#pragma unroll
                  for (int k = 0; k < 2; ++k) { const int c = 256 * k + 4 * F.lane; const f32x4 o = pv[q][k] * rs * gpv[k];
                      v2u w; w.x = pk2(o.x, o.y); w.y = pk2(o.z, o.w); *(v2u*)(y + (size_t)row * DM + 1024 + c) = w; } }
            }
        }
    }
}

__device__ __forceinline__ void dispatch_phase(Frame& F) {
    LAS int* pre = (LAS int*)F.lds;
    LAS int* tot = pre + 2048;
    LAS int* est = tot + 8;
    LAS int* ex = est + 16;
    LAS int* rw = ex + 256;
    __syncthreads();
    for (int i = F.tid; i < 2048; i += NTHR) pre[i] = F_grpcnt[i];
    __syncthreads();
    if (F.tid < 8) { int s = 0; for (int g = 0; g < 256; ++g) { const int v = pre[g * 8 + F.tid]; pre[g * 8 + F.tid] = s; s += v; } tot[F.tid] = s; }
    __syncthreads();
    if (F.tid == 0) { int s = 0; for (int e = 0; e < 8; ++e) { est[e] = s * 256; s += (tot[e] + 255) >> 8; } est[8] = s * 256;
        if (F.bid == 0) { for (int e = 0; e <= 8; ++e) F_pstart[e] = est[e] >> 8; } }
    __syncthreads();
    const bf16* h2 = uni_h(F);
    for (int g = F.bid; g < NLAT / 128; g += F.G) {
        __syncthreads();
        if (F.tid < 256) ex[F.tid] = F_top_e[g * 256 + F.tid];
        __syncthreads();
        if (F.tid < 256) { const int i = F.tid >> 1, e = ex[F.tid]; int rank = 0;
            for (int j = 0; j < i; ++j) rank += (ex[2 * j] == e) + (ex[2 * j + 1] == e);
            const int row = est[e] + pre[g * 8 + e] + rank; rw[F.tid] = row; F_tokrow[g * 256 + F.tid] = row; }
        __syncthreads();
#pragma unroll 1
        for (int i0 = 0; i0 < 256 * 128; i0 += 8 * NTHR) { v4u v[8];
#pragma unroll
            for (int k = 0; k < 8; ++k) { const int idx = i0 + k * NTHR + F.tid, r = idx >> 7, ch = idx & 127; v[k] = *(const v4u*)((const unsigned char*)h2 + (size_t)(g * 128 + (r >> 1)) * DM + ch * 16); }
#pragma unroll
            for (int k = 0; k < 8; ++k) { const int idx = i0 + k * NTHR + F.tid, r = idx >> 7, ch = idx & 127; *(v4u*)((unsigned char*)F_ag + (size_t)rw[r] * DM + ch * 16) = v[k]; } }
    }
    for (int e = F.bid; e < 8; e += F.G) { const int r0 = est[e] + tot[e], r1 = est[e + 1];
        for (int idx = F.tid; idx < (r1 - r0) * 128; idx += NTHR) *(v4u*)((unsigned char*)F_ag + (size_t)(r0 + (idx >> 7)) * DM + (idx & 127) * 16) = (v4u){0u, 0u, 0u, 0u}; }
}
__device__ __forceinline__ void moe_order_init(Frame& F, MoeOrder& S, int chunk, int nN, bool first) {
    const int* ps = F_pstart; const int P = ps[8];
    S.G = F.G; S.c = F.bid; S.nN = nN; S.p_lo = chunk * MOE_CAP_PANELS; const int hi = P < (chunk + 1) * MOE_CAP_PANELS ? P : (chunk + 1) * MOE_CAP_PANELS; S.np = hi > S.p_lo ? hi - S.p_lo : 0;
    S.a_off = first ? 0 : S.p_lo; S.o_off = first ? S.p_lo : 0; S.ps = ps;
}

__device__ __forceinline__ void final_phase(Frame& F) {
    const float* g2 = F_mod + (size_t)5 * MODW + 5 * DM;
    const float* fg = FIN(IN_FINALG);
    for (int rb = (F.bid * NWAVES + F.wave) * 16; rb < NLAT; rb += F.G * NWAVES * 16) {
        const float* gp = g2 + (size_t)(rb >> 13) * MODW;
        f32x4 gg[8], fgv[8];
#pragma unroll
        for (int k = 0; k < 8; ++k) { const int c = 512 * (k >> 1) + 8 * F.lane + 4 * (k & 1); gg[k] = *(const f32x4*)(gp + c); fgv[k] = *(const f32x4*)(fg + c); }
        v4u nx[4], na[4], nb[4]; float nw0, nw1;
#define FIN_LOAD(R_) do { const int r0_ = F_tokrow[(R_) * 2], r1_ = F_tokrow[(R_) * 2 + 1]; nw0 = F_gatew[(R_) * 2]; nw1 = F_gatew[(R_) * 2 + 1]; \
        _Pragma("unroll") for (int j = 0; j < 4; ++j) { const int c = 512 * j + 8 * F.lane; nx[j] = *(const v4u*)(F_x16 + (size_t)(R_) * DM + c); na[j] = *(const v4u*)(F_ye + (size_t)r0_ * DM + c); nb[j] = *(const v4u*)(F_ye + (size_t)r1_ * DM + c); } } while (0)
        FIN_LOAD(rb);
#pragma unroll 1
        for (int r = 0; r < 16; ++r) { const int row = rb + r;
            v4u cx[4], ca[4], cbv[4]; const float w0 = nw0, w1 = nw1;
#pragma unroll
            for (int j = 0; j < 4; ++j) { cx[j] = nx[j]; ca[j] = na[j]; cbv[j] = nb[j]; }
            if (r < 15) FIN_LOAD(row + 1);
            f32x4 v[8]; float ss = 0.f;
#pragma unroll
            for (int j = 0; j < 4; ++j) {
#pragma unroll
                for (int h = 0; h < 2; ++h) { const unsigned x0 = h ? cx[j].z : cx[j].x, x1 = h ? cx[j].w : cx[j].y, a0 = h ? ca[j].z : ca[j].x, a1 = h ? ca[j].w : ca[j].y, b0 = h ? cbv[j].z : cbv[j].x, b1 = h ? cbv[j].w : cbv[j].y;
                    const f32x4 x = (f32x4){__uint_as_float(x0 << 16), __uint_as_float(x0 & 0xffff0000u), __uint_as_float(x1 << 16), __uint_as_float(x1 & 0xffff0000u)};
                    f32x4 m; m.x = w0 * __uint_as_float(a0 << 16) + w1 * __uint_as_float(b0 << 16); m.y = w0 * __uint_as_float(a0 & 0xffff0000u) + w1 * __uint_as_float(b0 & 0xffff0000u);
                    m.z = w0 * __uint_as_float(a1 << 16) + w1 * __uint_as_float(b1 << 16); m.w = w0 * __uint_as_float(a1 & 0xffff0000u) + w1 * __uint_as_float(b1 & 0xffff0000u);
                    const f32x4 y = x + gg[2 * j + h] * m; v[2 * j + h] = y; ss += (y.x * y.x + y.y * y.y) + (y.z * y.z + y.w * y.w); } }
            const float rs = rsqrtf(wave_sum(ss) * (1.0f / DM) + EPS);
            float* xr = F.out + (size_t)row * DM;
#pragma unroll
            for (int k = 0; k < 8; ++k) *(f32x4*)(xr + 512 * (k >> 1) + 8 * F.lane + 4 * (k & 1)) = v[k] * rs * fgv[k];
        }
#undef FIN_LOAD
    }
}

template <class T> __device__ __forceinline__ T* launder_ptr(T* p) {
    unsigned lo = (unsigned)(uintptr_t)p, hi = (unsigned)((uintptr_t)p >> 32);
    asm volatile("" : "+v"(lo), "+v"(hi));
    lo = __builtin_amdgcn_readfirstlane(lo); hi = __builtin_amdgcn_readfirstlane(hi);
    typedef __attribute__((address_space(1))) T GT;
    return (T*)(GT*)(((uintptr_t)hi << 32) | (uintptr_t)lo);
}
__device__ __forceinline__ unsigned launder_u(unsigned v) { asm volatile("" : "+v"(v)); return (unsigned)__builtin_amdgcn_readfirstlane(v); }
__device__ __forceinline__ void fresh(Frame& F, const Args& args, const int wave0) {
    unsigned zz = 0u; asm volatile("" : "+v"(zz));
    const int tid = (int)((launder_u((unsigned)wave0) << 6) | __builtin_amdgcn_mbcnt_hi(~0u, __builtin_amdgcn_mbcnt_lo(~0u, zz)));
    F.ws = launder_ptr(args.ws); F.out = launder_ptr(args.out);
    { unsigned long long kp = (unsigned long long)(uintptr_t)__builtin_amdgcn_kernarg_segment_ptr(); unsigned lo = (unsigned)kp, hi = (unsigned)(kp >> 32); asm volatile("" : "+v"(lo), "+v"(hi));
      lo = __builtin_amdgcn_readfirstlane(lo); hi = __builtin_amdgcn_readfirstlane(hi); F.in = (const __attribute__((address_space(4))) unsigned long long*)(((unsigned long long)hi << 32) | lo); }
    F.tid = tid; F.lane = tid & 63; F.wave = __builtin_amdgcn_readfirstlane(tid >> 6);
    F.G = (int)launder_u(gridDim.x); F.bid = (int)launder_u(blockIdx.x);
    extern __shared__ __attribute__((aligned(16))) unsigned char lds_base[];
    F.lds = (LAS unsigned char*)(uintptr_t)launder_u((unsigned)(uintptr_t)(LAS unsigned char*)lds_base); F.ldsg = (unsigned char*)F.lds;
}
constexpr int PH_PRO = 0, PH_L0 = 1, PH_PER_LAYER = 9  , PH_FF1 = 10, PH_FF2 = 11, PH_L1 = 12, PH_DISP = 21, PH_MOE = 22  , PH_FINAL = 24, NPHASE = 25;

#define IN(k) (fresh(F, args, wave0), lo <= (k) && (k) < hi)
#define REP(k) (((PROBE_MASK >> (k)) & 1u) != 0u)
#define SEAM(k) do { if (IN(k) && IN((k) + 1)) { XcdBarrier bb; bb.bar = (unsigned*)(F.ws + WS_CTL) + CW_BAR; bb.x = xb_xcc_id(); bb.st = (volatile LAS unsigned*)(F.lds + LDSCTL_OFF); xcd_barrier(bb); } } while (0)

template <int LAYER>
__device__ __forceinline__ void layer_phases(Frame& F, const Args& args, const int lo, const int hi, const int wave0) {
    constexpr int pb = LAYER == 0 ? PH_L0 : PH_L1;
    if (IN(pb + 0)) norm_phase<0, false>(F, LAYER, MTOT);
    SEAM(pb + 0);
    if (IN(pb + 1)) {
        pg8::Gemm g{LAYER == 0 ? uni_winT(F, 0) : uni_h(F), LAYER == 0 ? uni_winT(F, 0) : uni_h(F), DM};
        WinOrder S; S.init(F.G, F.bid, LAYER);
        EpiIn E{F_proj, F_hyT, F_ropec, F_ropes};
        pg8::gemm_phase<EpiIn, WinOrder, true, true>(F.lds, g, S, E, F.tid);
    }
    SEAM(pb + 1);
    if (IN(pb + 2)) mixa_hyena(F, LAYER);
    if (IN(pb + 3)) mixa_ctx(F, LAYER);
    if (IN(pb + 4)) mixa_pool(F, LAYER);
    if (IN(pb + 5)) attn_phase_mfma(F, LAYER);
    SEAM(pb + 5);
    if (IN(pb + 6)) merge_phase(F, LAYER);
    SEAM(pb + 6);
    if (IN(pb + 7)) {
        pg8::Gemm g{uni_h(F), F_woutT + (size_t)LAYER * DM * DM, DM};
        pg8::StaticOrder S; S.init(LAYER == 0 ? MTOT : NLAT, DM, F.G, F.bid);
        EpiResid<LAYER == 0> E{FIN(IN_X), FIN(IN_CTX), F_x16, F_mod + (size_t)LAYER * 5 * MODW + 2 * DM, 1.0f};
        pg8::gemm_phase<EpiResid<LAYER == 0>, pg8::StaticOrder, true, true>(F.lds, g, S, E, F.tid);
    }
    SEAM(pb + 7);
    if (IN(pb + 8)) { if (LAYER == 0) norm_phase<1, false>(F, 0, MTOT); else norm_phase<1, true>(F, 1, NLAT); }
    SEAM(pb + 8);
    if constexpr (LAYER == 0) {
        if (IN(PH_FF1)) {
            pg8::Gemm g{uni_h(F), F_ff13T, DM / 2};
            pg8::StaticOrder S; S.init(MTOT, 2 * DFF, F.G, F.bid);
            EpiSwiglu E{F_hid, 1.0f / 64.0f, 1};
            pg8::gemm_phase<EpiSwiglu, pg8::StaticOrder, true, true, true>(F.lds, g, S, E, F.tid);
        }
        SEAM(PH_FF1);
        if (IN(PH_FF2)) {
            pg8::Gemm g{F_hid, F_ff2T, DFF / 2};
            pg8::StaticOrder S; S.init(MTOT, DM, F.G, F.bid);
            EpiResid<false> E{nullptr, nullptr, F_x16, F_mod + 5 * DM, 1.0f / 64.0f};
            pg8::gemm_phase<EpiResid<false>, pg8::StaticOrder, true, true, true>(F.lds, g, S, E, F.tid);
        }
        SEAM(PH_FF2);
    }
}
template <int CK>
__device__ __forceinline__ void moe_chunk(Frame& F, const Args& args, const int lo, const int hi, const int wave0) {
    if (IN(PH_MOE + 2 * CK)) {
        pg8::Gemm g{F_ag, F_moe13T, DM / 2};
        MoeOrder S; moe_order_init(F, S, CK, 2 * DFF / 256, true);
        EpiSwiglu E{F_hid, 1.0f / 64.0f, 1};
        pg8::gemm_phase<EpiSwiglu, MoeOrder, true, true, true>(F.lds, g, S, E, F.tid);
    }
    SEAM(PH_MOE + 2 * CK);
    if (IN(PH_MOE + 2 * CK + 1)) {
        pg8::Gemm g{F_hid, F_moe2T, DFF / 2};
        MoeOrder S; moe_order_init(F, S, CK, DM / 256, false);
        EpiBf16Plain E{F_ye, DM, 1.0f / 64.0f};
        pg8::gemm_phase<EpiBf16Plain, MoeOrder, true, true, true>(F.lds, g, S, E, F.tid);
    }
    SEAM(PH_MOE + 2 * CK + 1);
}

__global__ void __launch_bounds__(NTHR, 2) fwd_kernel(Args args) {
    const int wave0 = __builtin_amdgcn_readfirstlane((int)(threadIdx.x >> 6));
    Frame F;
    fresh(F, args, wave0);
    for (int u = F.tid; u < (LDS_BYTES - LDSCTL_OFF) / 4; u += NTHR) ((LAS unsigned*)(F.lds + LDSCTL_OFF))[u] = 0u;
    __syncthreads();
    if (!MK_PER_PHASE) (void)xcd_barrier_post((unsigned*)(args.ws + WS_CTL) + CW_BAR, (volatile LAS unsigned*)(F.lds + LDSCTL_OFF));
    const int lo = args.ph_lo, hi = args.ph_hi;

    if (IN(PH_PRO) && F.bid < PB) p0_mod(F);
    if (IN(PH_PRO) && F.bid < PB) p0_tables(F);
    if (IN(PH_PRO)) p0_weights(F);
    SEAM(PH_PRO);
#ifdef PROBE_LIST
    if (IN(100)) p0_weights(F);
    if (IN(101)) p0_mod(F);
    if (IN(102)) p0_tables(F);
#endif
    layer_phases<0>(F, args, lo, hi, wave0);
    layer_phases<1>(F, args, lo, hi, wave0);
    if (IN(PH_DISP)) dispatch_phase(F);
    SEAM(PH_DISP);
    moe_chunk<0>(F, args, lo, hi, wave0);
    if (IN(PH_FINAL)) final_phase(F);
}
#undef IN
#undef SEAM

extern "C" void kernel_launch(void* const* d_in, const int* in_sizes, int n_in, void* d_out, int out_size, void* d_ws, size_t ws_size, hipStream_t stream) {
    static int grid = 0;
    if (grid == 0) {
        if (n_in != 34 || in_sizes[0] != NLAT * DM || out_size != NLAT * DM || ws_size < WS_END) {
            fprintf(stderr, "kernel_launch: shape/workspace mismatch: n_in %d in0 %d out %d ws %zu (need %zu); nothing launched\n", n_in, n_in > 0 ? in_sizes[0] : -1, out_size, ws_size, (size_t)WS_END); grid = -1; return; }
        int dev = 0, cus = 0, per_cu = 0;
        if (hipGetDevice(&dev) != hipSuccess || hipDeviceGetAttribute(&cus, hipDeviceAttributeMultiprocessorCount, dev) != hipSuccess) { grid = -1; return; }
        if (hipFuncSetAttribute((const void*)fwd_kernel, hipFuncAttributeMaxDynamicSharedMemorySize, LDS_BYTES) != hipSuccess) { fprintf(stderr, "kernel_launch: hipFuncSetAttribute failed\n"); grid = -1; return; }
        if (hipOccupancyMaxActiveBlocksPerMultiprocessor(&per_cu, (const void*)fwd_kernel, NTHR, LDS_BYTES) != hipSuccess || per_cu < 1) { fprintf(stderr, "kernel_launch: occupancy query says %d\n", per_cu); (void)hipGetLastError(); grid = -1; return; }
        grid = cus < 256 ? cus : 256;
    }
    if (grid < 0) return;
    if (hipMemsetAsync((char*)d_ws + WS_CTL, 0, CTL_ZERO_BYTES, stream) != hipSuccess) return;
    Args a{};
    for (int i = 0; i < 34; ++i) a.in[i] = (const float*)d_in[i];
    a.out = (float*)d_out; a.ws = (unsigned char*)d_ws;
#if MK_PER_PHASE
    for (int k = 0; k < NPHASE; ++k) { a.ph_lo = k; a.ph_hi = k + 1; hipLaunchKernelGGL(fwd_kernel, dim3(grid), dim3(NTHR), LDS_BYTES, stream, a); }
#else
    a.ph_lo = 0; a.ph_hi = NPHASE;
    hipLaunchKernelGGL(fwd_kernel, dim3(grid), dim3(NTHR), LDS_BYTES, stream, a);
#ifdef PROBE_LIST
    { static const int probe[][2] = {PROBE_LIST}; for (unsigned i = 0; i < sizeof(probe) / sizeof(probe[0]); ++i) { a.ph_lo = probe[i][0]; a.ph_hi = probe[i][1]; hipLaunchKernelGGL(fwd_kernel, dim3(grid), dim3(NTHR), LDS_BYTES, stream, a); } }
#endif
#endif
    const hipError_t le = hipPeekAtLastError();
    if (le != hipSuccess) fprintf(stderr, "kernel_launch: launch failed: %s\n", hipGetErrorName(le));
}
```

```cpp
#include <hip/hip_runtime.h>
#include <cstdio>
#include <cstdint>

#ifndef MK_PER_PHASE
#define MK_PER_PHASE 0
#endif
#ifndef PROBE_MASK
#define PROBE_MASK 0u
#endif

namespace pg8 {
#define PG8_LAS __attribute__((address_space(3)))
typedef unsigned short bf16_t;
typedef short bf16x8 __attribute__((ext_vector_type(8)));
typedef float f32x4 __attribute__((ext_vector_type(4)));
typedef unsigned u32x4 __attribute__((ext_vector_type(4)));
constexpr int BM = 256, BK = 64, HALF = 128, HTB = HALF * BK * 2, STAGE_BYTES = 8 * HTB, NXCD = 8, WGM = 8;

__host__ __device__ __forceinline__ int lds_byte(int r, int c) { const int st = (r >> 4) * 2 + (c >> 5), rr = r & 15, cc = c & 31, ob = rr * 64 + cc * 2; return st * 1024 + (ob ^ (((ob >> 9) & 1) << 5)); }
__host__ __device__ __forceinline__ void stage_rc(int b, int& R, int& C) { const int st = b / 1024, sb = b % 1024, swz = sb ^ (((sb >> 9) & 1) << 5); R = (st >> 1) * 16 + swz / 64; C = (st & 1) * 32 + (swz % 64) / 2; }
__host__ __device__ __forceinline__ int perm32(int rho) { const int n = rho >> 4, i = rho & 15; return 8 * (i >> 2) + 4 * n + (i & 3); }

struct Unit { int pm, pn, orow, ocol, kind; };
struct Gemm { const bf16_t* A; const bf16_t* Bt; int K; };

struct StaticOrder {
    int nM, nN, nwg, G, c;
    __host__ __device__ void init(int M, int N, int G_, int c_) { nM = M / BM; nN = N / BM; nwg = nM * nN; G = G_; c = c_; }
    __host__ __device__ void map(int L, int& pm, int& pn) const {
        int wgid = L; { const int q = nwg / NXCD, r = nwg % NXCD, xcd = wgid % NXCD, off = wgid / NXCD; wgid = (xcd < r ? xcd * (q + 1) : r * (q + 1) + (xcd - r) * q) + off; }
        const int nig = WGM * nN, gid = wgid / nig, fm = gid * WGM, gsz = (nM - fm) < WGM ? (nM - fm) : WGM;
        pm = fm + ((wgid % nig) % gsz); pn = (wgid % nig) / gsz;
    }
    __host__ __device__ bool next(int i, Unit& u) const {
        const long L = (long)i * G + c; if (L >= nwg) return false;
        int pm, pn; map((int)L, pm, pn); u.pm = pm; u.pn = pn; u.orow = pm * BM; u.ocol = pn * BM; u.kind = 0; return true;
    }
    __device__ __forceinline__ void a_ready(const Unit&) const {}
    __device__ __forceinline__ void done(const Unit&) const {}
};

__device__ __forceinline__ unsigned cvt_pk_bf16(float lo, float hi) { unsigned r; asm volatile("v_cvt_pk_bf16_f32 %0, %1, %2" : "=v"(r) : "v"(lo), "v"(hi)); return r; }

template <bool F8> struct pg8_frag;
template <> struct pg8_frag<false> { struct T { bf16x8 k0, k1; };
    static __device__ __forceinline__ T load(const PG8_LAS u32x4* p0, const PG8_LAS u32x4* p1) { T t; t.k0 = __builtin_bit_cast(bf16x8, *p0); t.k1 = __builtin_bit_cast(bf16x8, *p1); return t; }
    static __device__ __forceinline__ f32x4 mma(const T& b, const T& a, f32x4 c) { c = __builtin_amdgcn_mfma_f32_16x16x32_bf16(b.k0, a.k0, c, 0, 0, 0); return __builtin_amdgcn_mfma_f32_16x16x32_bf16(b.k1, a.k1, c, 0, 0, 0); } };
template <> struct pg8_frag<true> { typedef int T __attribute__((ext_vector_type(8)));
    static __device__ __forceinline__ T load(const PG8_LAS u32x4* p0, const PG8_LAS u32x4* p1) { const u32x4 a = *p0, b = *p1; return (T){(int)a.x, (int)a.y, (int)a.z, (int)a.w, (int)b.x, (int)b.y, (int)b.z, (int)b.w}; }
    static __device__ __forceinline__ f32x4 mma(const T& b, const T& a, f32x4 c) { const int one = 0x7f7f7f7f;
        asm volatile("v_mfma_scale_f32_16x16x128_f8f6f4 %0, %1, %2, %0, %3, %3 op_sel_hi:[0,0,0]" : "+v"(c) : "v"(b), "v"(a), "v"(one)); return c; } };
template <class Epi, class Sched, bool ALIGN_EPI = false, bool SP2 = false, bool F8 = false>
__device__ __forceinline__ void gemm_phase(PG8_LAS unsigned char* lds, const Gemm g, const Sched& S, const Epi& E, const int tid) {
    const int wid = __builtin_amdgcn_readfirstlane(tid >> 6), lane = tid & 63, wr = wid >> 2, wc = wid & 3, fr = lane & 15, fq = lane >> 4;
    const int K = g.K, nt = K / BK;
    unsigned voffA[2], voffB[2];
#pragma unroll
    for (int i = 0; i < 2; ++i) { int R, C; stage_rc(tid * 16 + i * 8192, R, C); const int Rb = Epi::PERM ? ((R & ~31) + perm32(R & 31)) : R;
        voffA[i] = (unsigned)(R * K + C) * 2u; voffB[i] = (unsigned)(Rb * K + C) * 2u; }
    const size_t kstep = (size_t)(BK * 2);
    const size_t hstep = (size_t)HALF * K * 2;
    const size_t tstep = 2 * hstep;
    const unsigned ldsw = (unsigned)wid * 1024u;
    const int aoff = lds_byte(wr * 64 + fr, fq * 8), boff = lds_byte(wc * 32 + fr, fq * 8);
#define PG8_SA(b, h) (((b) * 2 + (h)) * HTB)
#define PG8_SB(b, h) ((4 + (b) * 2 + (h)) * HTB)
#define PG8_STAGE(bufoff, gbase, voff) do { _Pragma("unroll") for (int _i = 0; _i < 2; ++_i) \
        __builtin_amdgcn_global_load_lds((const unsigned*)((const char*)(gbase) + (voff)[_i]), (PG8_LAS unsigned*)(lds + (bufoff) + ldsw + _i * 8192), 16, 0, 0); } while (0)
#define PG8_LDF(p) pg8_frag<F8>::load((const PG8_LAS u32x4*)(p), (const PG8_LAS u32x4*)((p) + 1024))
#define PG8_LDA(dst, b, h) do { _Pragma("unroll") for (int m = 0; m < 4; ++m) dst[m] = PG8_LDF(lds + PG8_SA(b, h) + aoff + m * 2048); } while (0)
#define PG8_LDB(dst, b, h) do { _Pragma("unroll") for (int n = 0; n < 2; ++n) dst[n] = PG8_LDF(lds + PG8_SB(b, h) + boff + n * 2048); } while (0)
#define PG8_MMA(ai, bj, At, Bt) do { __builtin_amdgcn_s_setprio(1); _Pragma("unroll") for (int m = 0; m < 4; ++m) _Pragma("unroll") for (int n = 0; n < 2; ++n) \
        acc[ai][bj][m][n] = pg8_frag<F8>::mma(Bt[n], At[m], acc[ai][bj][m][n]); __builtin_amdgcn_s_setprio(0); } while (0)
#define PG8_WAIT_V(n) asm volatile("s_waitcnt vmcnt(" #n ")" ::: "memory")
#define PG8_WAIT_L(n) asm volatile("s_waitcnt lgkmcnt(" #n ")" ::: "memory")
#define PG8_BAR __builtin_amdgcn_s_barrier()
#define PG8_SCHED __builtin_amdgcn_sched_barrier(0)
    Unit cur, nxt; int ui = 0;
    if (!S.next(0, cur)) return;
    f32x4 acc[2][2][4][2];
#pragma unroll
    for (int a = 0; a < 2; ++a)
#pragma unroll
        for (int b = 0; b < 2; ++b)
#pragma unroll
            for (int m = 0; m < 4; ++m)
#pragma unroll
                for (int n = 0; n < 2; ++n) acc[a][b][m][n] = (f32x4){0.f, 0.f, 0.f, 0.f};
    typename pg8_frag<F8>::T At[4], B0[2], B1[2];
    const char* cA = (const char*)g.A + (size_t)cur.pm * tstep; const char* cB = (const char*)g.Bt + (size_t)cur.pn * tstep;
    S.a_ready(cur);
    if constexpr (SP2) {
        PG8_STAGE(PG8_SB(0, 0), cB, voffB); PG8_STAGE(PG8_SB(0, 1), cB + hstep, voffB); PG8_STAGE(PG8_SA(0, 0), cA, voffA); PG8_STAGE(PG8_SA(0, 1), cA + hstep, voffA);
        if (wr == 1) PG8_BAR;
        PG8_WAIT_V(2); PG8_BAR;
        PG8_STAGE(PG8_SB(1, 0), cB + kstep, voffB); PG8_STAGE(PG8_SA(1, 0), cA + kstep, voffA); PG8_STAGE(PG8_SB(1, 1), cB + hstep + kstep, voffB);
        PG8_WAIT_V(6); PG8_BAR;
    } else {
        PG8_STAGE(PG8_SB(0, 0), cB, voffB); PG8_STAGE(PG8_SA(0, 0), cA, voffA); PG8_STAGE(PG8_SB(0, 1), cB + hstep, voffB); PG8_STAGE(PG8_SA(0, 1), cA + hstep, voffA);
        if (wr == 1) PG8_BAR;
        PG8_WAIT_V(4); PG8_BAR;
        PG8_STAGE(PG8_SB(1, 0), cB + kstep, voffB); PG8_STAGE(PG8_SA(1, 0), cA + kstep, voffA); PG8_STAGE(PG8_SB(1, 1), cB + hstep + kstep, voffB);
        PG8_WAIT_V(6); PG8_BAR;
    }
    for (;;) {
        const bool has_next = S.next(ui + 1, nxt);
        const char* nA = has_next ? (const char*)g.A + (size_t)nxt.pm * tstep : cA; const char* nB = has_next ? (const char*)g.Bt + (size_t)nxt.pn * tstep : cB;
        for (int t = 0; t < nt; t += 2) {
            const bool last = (t == nt - 2);
            const char* a1 = cA + (size_t)(t + 1) * kstep;
            const char* a2 = last ? nA : cA + (size_t)(t + 2) * kstep; const char* b2 = last ? nB : cB + (size_t)(t + 2) * kstep;
            const char* a3 = a2 + kstep; const char* b3 = b2 + kstep;
            if (last && has_next) S.a_ready(nxt);
            if constexpr (SP2) {
            PG8_LDB(B0, 0, 0); PG8_LDB(B1, 0, 1); PG8_SCHED; PG8_LDA(At, 0, 0); PG8_STAGE(PG8_SA(1, 1), a1 + hstep, voffA);
            PG8_WAIT_V(8); PG8_WAIT_L(0); PG8_BAR; PG8_MMA(0, 0, At, B0); PG8_MMA(0, 1, At, B1); PG8_BAR; PG8_SCHED;
            PG8_LDA(At, 0, 1); PG8_STAGE(PG8_SB(0, 0), b2, voffB); PG8_STAGE(PG8_SB(0, 1), b2 + hstep, voffB); PG8_STAGE(PG8_SA(0, 0), a2, voffA);
            PG8_WAIT_V(8); PG8_WAIT_L(0); PG8_BAR; PG8_MMA(1, 0, At, B0); PG8_MMA(1, 1, At, B1); PG8_BAR; PG8_SCHED;
            PG8_LDB(B0, 1, 0); PG8_LDB(B1, 1, 1); PG8_SCHED; PG8_LDA(At, 1, 0); PG8_STAGE(PG8_SA(0, 1), a2 + hstep, voffA);
            PG8_WAIT_V(8); PG8_WAIT_L(0); PG8_BAR; PG8_MMA(0, 0, At, B0); PG8_MMA(0, 1, At, B1); PG8_BAR; PG8_SCHED;
            PG8_LDA(At, 1, 1); PG8_STAGE(PG8_SB(1, 0), b3, voffB); PG8_STAGE(PG8_SB(1, 1), b3 + hstep, voffB); PG8_STAGE(PG8_SA(1, 0), a3, voffA);
            PG8_WAIT_V(8); PG8_WAIT_L(0); PG8_BAR; PG8_MMA(1, 0, At, B0); PG8_MMA(1, 1, At, B1); PG8_BAR; PG8_SCHED;
            } else {
            PG8_LDB(B0, 0, 0); PG8_SCHED; PG8_LDA(At, 0, 0); PG8_STAGE(PG8_SA(1, 1), a1 + hstep, voffA);
            PG8_WAIT_L(8); PG8_BAR; PG8_WAIT_L(0); PG8_MMA(0, 0, At, B0); PG8_BAR; PG8_SCHED;
            PG8_LDB(B1, 0, 1); PG8_STAGE(PG8_SB(0, 0), b2, voffB);
            PG8_BAR; PG8_WAIT_L(0); PG8_MMA(0, 1, At, B1); PG8_BAR;
            PG8_LDA(At, 0, 1); PG8_STAGE(PG8_SA(0, 0), a2, voffA);
            PG8_BAR; PG8_WAIT_L(0); PG8_MMA(1, 0, At, B0); PG8_BAR; PG8_SCHED;
            PG8_STAGE(PG8_SB(0, 1), b2 + hstep, voffB);
            PG8_WAIT_V(6); PG8_BAR; PG8_MMA(1, 1, At, B1); PG8_BAR;
            PG8_LDB(B0, 1, 0); PG8_SCHED; PG8_LDA(At, 1, 0); PG8_STAGE(PG8_SA(0, 1), a2 + hstep, voffA);
            PG8_WAIT_L(8); PG8_BAR; PG8_WAIT_L(0); PG8_MMA(0, 0, At, B0); PG8_BAR; PG8_SCHED;
            PG8_LDB(B1, 1, 1); PG8_STAGE(PG8_SB(1, 0), b3, voffB);
            PG8_BAR; PG8_WAIT_L(0); PG8_MMA(0, 1, At, B1); PG8_BAR;
            PG8_LDA(At, 1, 1); PG8_STAGE(PG8_SA(1, 0), a3, voffA);
            PG8_BAR; PG8_WAIT_L(0); PG8_MMA(1, 0, At, B0); PG8_BAR; PG8_SCHED;
            PG8_STAGE(PG8_SB(1, 1), b3 + hstep, voffB);
            PG8_WAIT_V(6); PG8_BAR; PG8_MMA(1, 1, At, B1); PG8_BAR;
            }
        }
        if constexpr (ALIGN_EPI) { if (wr == 0) PG8_BAR; }
        if constexpr (F8) asm volatile("s_nop 15\n\ts_nop 15" ::: "memory");
        E(acc, cur, wr, wc, fr, fq); S.done(cur);
        if (!has_next) break;
#pragma unroll
        for (int a = 0; a < 2; ++a)
#pragma unroll
            for (int b = 0; b < 2; ++b)
#pragma unroll
                for (int m = 0; m < 4; ++m)
#pragma unroll
                    for (int n = 0; n < 2; ++n) acc[a][b][m][n] = (f32x4){0.f, 0.f, 0.f, 0.f};
        cur = nxt; cA = nA; cB = nB; ++ui;
        if constexpr (ALIGN_EPI) { if (wr == 1) PG8_BAR; }
    }
    PG8_WAIT_V(0);
    if constexpr (!ALIGN_EPI) { if (wr == 0) PG8_BAR; }
    PG8_BAR;
#undef PG8_SA
#undef PG8_SB
#undef PG8_STAGE
#undef PG8_LDA
#undef PG8_LDB
#undef PG8_MMA
#undef PG8_WAIT_V
#undef PG8_WAIT_L
#undef PG8_BAR
#undef PG8_SCHED
}
}

typedef unsigned short bf16;
typedef float f32x4 __attribute__((ext_vector_type(4)));
typedef float f32x2 __attribute__((ext_vector_type(2)));
typedef unsigned v4u __attribute__((ext_vector_type(4)));
typedef unsigned v2u __attribute__((ext_vector_type(2)));
#define LAS __attribute__((address_space(3)))
#define GAS __attribute__((address_space(1)))

constexpr int NWAVES = 8, NTHR = 512;
constexpr int DM = 2048, NBATCH = 4, SEQ = 8192, NLAT = NBATCH * SEQ, CTXL = 256, NCTX = NBATCH * CTXL, MTOT = NLAT + NCTX;
constexpr int ATTW = 1024, KVW = 256, POOLW = 512, HYW = 512, HYP = 1536, INW = 3584, QKVP = 2048;
constexpr int DFF = 5632, NEXP = 8;
constexpr int MODW = 6 * DM;
constexpr float EPS = 1e-6f;
constexpr int MOE_CAP_PANELS = 264;
constexpr int MOE_MAX_ROWS = 2 * NLAT + NEXP * 256;

constexpr size_t MiB = 1u << 20;
constexpr size_t WS_CTL = 0;
constexpr size_t CTL_ZERO_BYTES = 1 * MiB;
constexpr size_t WS_MOD = 1 * MiB;
constexpr size_t WS_ROPE = 2 * MiB;
constexpr size_t WS_A2 = 3 * MiB;
constexpr size_t WS_ROUTE = 8 * MiB;
constexpr size_t WS_TW = 9 * MiB;
constexpr size_t WS_DFT = 20 * MiB;
constexpr size_t WS_A2B = 18 * MiB;
constexpr size_t WS_POOLWT = 9 * MiB + 512 * 1024;
constexpr size_t WS_XC = 10 * MiB;
constexpr size_t WS_UNI = 32 * MiB;
constexpr size_t UNI_BYTES = (size_t)(INW + MTOT + INW) * DM * 2;
constexpr size_t WS_WOUT = WS_UNI + UNI_BYTES;
constexpr size_t WS_FF13 = WS_WOUT + 16 * MiB;
constexpr size_t WS_FF2 = WS_FF13 + 22 * MiB;
constexpr size_t WS_MOE13 = WS_FF2 + 11 * MiB;
constexpr size_t WS_MOE2 = WS_MOE13 + 176 * MiB;
constexpr size_t WS_R = WS_MOE2 + 88 * MiB;
constexpr size_t WS_PROJ = WS_R;
constexpr size_t WS_HYT = WS_PROJ + (size_t)MTOT * QKVP * 2;
constexpr size_t WS_ATT = WS_HYT + (size_t)HYP * MTOT * 2;
constexpr size_t WS_POOL = WS_ATT + (size_t)MTOT * ATTW * 4;
constexpr size_t WS_ZT = WS_POOL + (size_t)MTOT * POOLW * 4;
constexpr size_t WS_KF = WS_ZT + (size_t)HYW * MTOT * 4;
constexpr size_t WS_HS = WS_KF + (size_t)256 * 2 * 16384 * 8;
constexpr size_t WS_R_MIX_END = WS_HS + (size_t)256 * 6 * 8192 * 4;
constexpr size_t WS_HID = WS_R;
constexpr size_t WS_AG = WS_HID + (size_t)MTOT * DFF * 2;
constexpr size_t WS_R_FFN_END = WS_AG + (size_t)MOE_MAX_ROWS * DM * 2;
constexpr size_t WS_YE = (WS_R_FFN_END > WS_R_MIX_END ? WS_R_FFN_END : WS_R_MIX_END);
constexpr size_t WS_X16 = WS_YE + (size_t)MOE_MAX_ROWS * DM * 2;
constexpr size_t WS_END = WS_X16 + (size_t)MTOT * DM * 2;

constexpr int CW_BAR = 4096;
constexpr int LDS_BYTES = 147456;
constexpr int LDSCTL_OFF = LDS_BYTES - 256;
constexpr int LDS_USABLE = LDSCTL_OFF;

__device__ __forceinline__ float bf2f(bf16 b) { return __uint_as_float(((unsigned)b) << 16); }
__device__ __forceinline__ unsigned f2bf(float f) { unsigned u = __float_as_uint(f); return (u + 0x7fffu + ((u >> 16) & 1u)) >> 16; }
__device__ __forceinline__ unsigned pk2(float lo, float hi) { return f2bf(lo) | (f2bf(hi) << 16); }
__device__ __forceinline__ float wave_sum(float v) {
#pragma unroll
    for (int o = 1; o < 64; o <<= 1) v += __shfl_xor(v, o);
    return v;
}
__device__ __forceinline__ float wave_max(float v) {
#pragma unroll
    for (int o = 1; o < 64; o <<= 1) v = fmaxf(v, __shfl_xor(v, o));
    return v;
}
__device__ __forceinline__ float silu_f(float x) { return x / (1.0f + __expf(-x)); }
#define LDS_WAIT() asm volatile("s_waitcnt lgkmcnt(0)" ::: "memory")

#define XB_TMO      128
#define XB_XCNT(j)  (256  + 64 * (j))
#define XB_XSUB(j)  (1280 + 64 * (j))
#define XB_XGEN(j)  (2304 + 64 * (j))
#define XB_TOP      3328
#define XB_TOPGEN   3392
#define XCD_BAR_WORDS 3456
#define XB_SPIN_CAP (1u << 22)

__device__ __forceinline__ unsigned xb_ld(unsigned* p)              { return __hip_atomic_load(p, __ATOMIC_RELAXED, __HIP_MEMORY_SCOPE_AGENT); }
__device__ __forceinline__ unsigned xb_add(unsigned* p, unsigned v) { return __hip_atomic_fetch_add(p, v, __ATOMIC_RELAXED, __HIP_MEMORY_SCOPE_AGENT); }
__device__ __forceinline__ unsigned xb_xcc_id() { return (unsigned)__builtin_amdgcn_s_getreg((3 << 11) | 20) & 0xFu; }
#define XB_SPIN(cond, bar) do { unsigned _sp = 0; while (cond) { __builtin_amdgcn_s_sleep(1); \
    if ((++_sp & 255u) == 0u) { if (xb_ld(&(bar)[XB_TMO])) break; if (_sp > XB_SPIN_CAP) { atomicAdd(&(bar)[XB_TMO], 1u); break; } } } } while (0)

struct XcdBarrier { unsigned* bar; unsigned x; volatile LAS unsigned* st; };

__device__ __forceinline__ XcdBarrier xcd_barrier_post(unsigned* bar, volatile LAS unsigned* st) {
    XcdBarrier b; b.bar = bar; b.x = xb_xcc_id(); b.st = st;
    if (threadIdx.x == 0) (void)xb_add(&bar[XB_XCNT(b.x)], 1u);
    return b;
}
__device__ __forceinline__ void xcd_barrier_complete(unsigned* bar, unsigned x, unsigned& nloc, unsigned& nx) {
    const unsigned G = gridDim.x * gridDim.y * gridDim.z;
    unsigned sum, cnt, mine, sp = 0u;
    for (;;) {
        sum = 0u; cnt = 0u; mine = 0u;
#pragma unroll
        for (unsigned j = 0; j < 16; ++j) { const unsigned c = xb_ld(&bar[XB_XCNT(j)]); sum += c; cnt += (c > 0u) ? 1u : 0u; mine = (j == x) ? c : mine; }
        if (sum == G) break;
        __builtin_amdgcn_s_sleep(1);
        if ((++sp & 255u) == 0u) { if (xb_ld(&bar[XB_TMO])) break; if (sp > XB_SPIN_CAP) { atomicAdd(&bar[XB_TMO], 1u); break; } }
    }
    nloc = mine > 0u ? mine : 1u; nx = cnt > 0u ? cnt : 1u;
}
__device__ __forceinline__ void xcd_barrier(const XcdBarrier& b) {
    asm volatile("s_waitcnt vmcnt(0)" ::: "memory");
    __syncthreads();
    if (threadIdx.x == 0) {
        unsigned* bar = b.bar;
        __builtin_amdgcn_s_waitcnt(0);
        unsigned nloc = b.st[0], nx = b.st[1];
        if (nloc == 0u) { xcd_barrier_complete(bar, b.x, nloc, nx); b.st[0] = nloc; b.st[1] = nx; }
        const unsigned old = xb_add(&bar[XB_XSUB(b.x)], 1u);
        const unsigned gen = old / nloc;
        if (old + 1u == (gen + 1u) * nloc) {
            __builtin_amdgcn_fence(__ATOMIC_RELEASE, "agent");
            asm volatile("s_waitcnt vmcnt(0)" ::: "memory");
            const unsigned og = xb_add(&bar[XB_TOP], 1u);
            const unsigned tg = og / nx;
            if (og + 1u == (tg + 1u) * nx) xb_add(&bar[XB_TOPGEN], 1u);
            else XB_SPIN(xb_ld(&bar[XB_TOPGEN]) == tg, bar);
            __builtin_amdgcn_fence(__ATOMIC_ACQUIRE, "agent");
            xb_add(&bar[XB_XGEN(b.x)], 1u);
            asm volatile("s_waitcnt vmcnt(0)" ::: "memory");
        } else {
            XB_SPIN(xb_ld(&bar[XB_XGEN(b.x)]) == gen, bar);
            __builtin_amdgcn_fence(__ATOMIC_ACQUIRE, "agent");
            asm volatile("s_waitcnt vmcnt(0)" ::: "memory");
        }
    }
    __syncthreads();
}

struct Args { const float* in[34]; float* out; unsigned char* ws; int ph_lo, ph_hi; };
enum { IN_X = 0, IN_C, IN_CTX, IN_CCTX, IN_WMOD, IN_BMOD, IN_N1G, IN_WIN, IN_SINK, IN_POOLW, IN_POOLS, IN_HCW, IN_HCB, IN_FW1, IN_FB1, IN_FW2, IN_FB2, IN_FW3, IN_FB3, IN_FFREQ,
       IN_HBIAS, IN_GATT, IN_GPOOL, IN_GHY, IN_WOUT, IN_N2G, IN_FF1, IN_FF3, IN_FF2, IN_ROUTER, IN_MOE1, IN_MOE3, IN_MOE2, IN_FINALG };

struct Frame {
    LAS unsigned char* lds; unsigned char* ldsg;
    int tid, lane, wave, G, bid;
    const __attribute__((address_space(4))) unsigned long long* in; float* out; unsigned char* ws;
};
#define FIN(k) ((const float*)(const __attribute__((address_space(1))) float*)F.in[k])
#define F_mod    ((float*)(F.ws + WS_MOD))
#define F_ropec  ((float*)(F.ws + WS_ROPE))
#define F_ropes  ((float*)(F.ws + WS_ROPE) + 128 * 32)
#define F_a2     ((float*)(F.ws + WS_A2))
#define F_a2c    ((float*)(F.ws + WS_A2) + 2 * 8192 * 64)
#define F_top_e  ((int*)(F.ws + WS_ROUTE))
#define F_gatew  ((float*)(F.ws + WS_ROUTE + 256 * 1024))
#define F_tokrow ((int*)(F.ws + WS_ROUTE + 512 * 1024))
#define F_grpcnt ((int*)(F.ws + WS_ROUTE + 768 * 1024))
#define F_pstart ((int*)(F.ws + WS_ROUTE + 768 * 1024) + 2048)
#define F_xc     ((float*)(F.ws + WS_XC))
#define F_x16    ((bf16*)(F.ws + WS_X16))
#define F_uni    ((bf16*)(F.ws + WS_UNI))
#define F_woutT  ((bf16*)(F.ws + WS_WOUT))
#define F_ff13T  ((bf16*)(F.ws + WS_FF13))
#define F_ff2T   ((bf16*)(F.ws + WS_FF2))
#define F_moe13T ((bf16*)(F.ws + WS_MOE13))
#define F_moe2T  ((bf16*)(F.ws + WS_MOE2))
#define F_proj   ((bf16*)(F.ws + WS_PROJ))
#define F_hyT    ((bf16*)(F.ws + WS_HYT))
#define F_att    ((float*)(F.ws + WS_ATT))
#define F_pool   ((float*)(F.ws + WS_POOL))
#define F_zT     ((float*)(F.ws + WS_ZT))
#define F_hid    ((bf16*)(F.ws + WS_HID))
#define F_ag     ((bf16*)(F.ws + WS_AG))
#define F_ye     ((bf16*)(F.ws + WS_YE))
__device__ __forceinline__ bf16* uni_winT(const Frame& F, int l) { return F_uni + (l == 0 ? (size_t)0 : (size_t)(INW + MTOT) * DM); }
__device__ __forceinline__ bf16* uni_h(const Frame& F) { return F_uni + (size_t)INW * DM; }
__device__ __forceinline__ const float* xsrc_row(const Frame& F, int layer, int row) {
    if (row < NLAT) return (layer == 0 ? FIN(IN_X) : (const float*)F.out) + (size_t)row * DM;
    return (layer == 0 ? FIN(IN_CTX) : (const float*)F_xc) + (size_t)(row - NLAT) * DM;
}
__device__ __forceinline__ float* xw_row(const Frame& F, int row) { return row < NLAT ? F.out + (size_t)row * DM : F_xc + (size_t)(row - NLAT) * DM; }
__device__ __forceinline__ int mod_idx(int row) { return row < NLAT ? (row >> 13) : 4; }

__device__ __forceinline__ int dst_row_of(int kind, int n) {
    if (kind == 0) return n;
    if (kind == 1) {
        if (n >= 1280) return n;
        const int d = n & 127, hf = d >> 6, s = (d >> 5) & 1, i = d & 31, g = hf * 8 + (i >> 2), j = i & 3;
        return (n & ~127) + 8 * g + 4 * s + j;
    }
    if (kind == 2) return (n >> 7) * 256 + (n & 127);
    return (n >> 7) * 256 + 128 + (n & 127);
}
#define PB (F.G > 1 ? (F.G >> 1) : 1)
struct WItem { const float* W; bf16* WT; int K, N, kind, k0, n0, f8; };
__device__ __forceinline__ bool witem_decode(const Frame& F, int it, WItem& w) {
    constexpr int I_IN = (DM / 64) * (INW / 64), I_OUT = (DM / 64) * (DM / 64), I_13 = (DM / 64) * (DFF / 64), I_2 = (DFF / 64) * (DM / 64);
    constexpr int NIT = 2 * I_IN + 2 * I_OUT + 2 * I_13 + I_2 + NEXP * (2 * I_13 + I_2);
    if (it >= NIT) return false;
    int r = it; w.f8 = 0;
    if (r < 2 * I_IN) { const int l = r / I_IN; r %= I_IN; w.W = FIN(IN_WIN) + (size_t)l * DM * INW; w.K = DM; w.N = INW; w.WT = uni_winT(F, l); w.kind = 1; }
    else if ((r -= 2 * I_IN) < 2 * I_OUT) { const int l = r / I_OUT; r %= I_OUT; w.W = FIN(IN_WOUT) + (size_t)l * DM * DM; w.K = DM; w.N = DM; w.WT = F_woutT + (size_t)l * DM * DM; w.kind = 0; }
    else if ((r -= 2 * I_OUT) < I_13) { w.W = FIN(IN_FF1); w.K = DM; w.N = DFF; w.WT = F_ff13T; w.kind = 2; w.f8 = 1; }
    else if ((r -= I_13) < I_13) { w.W = FIN(IN_FF3); w.K = DM; w.N = DFF; w.WT = F_ff13T; w.kind = 3; w.f8 = 1; }
    else if ((r -= I_13) < I_2) { w.W = FIN(IN_FF2); w.K = DFF; w.N = DM; w.WT = F_ff2T; w.kind = 0; w.f8 = 1; }
    else { r -= I_2; const int e = r / (2 * I_13 + I_2); r -= e * (2 * I_13 + I_2);
        if (r < I_13) { w.W = FIN(IN_MOE1) + (size_t)e * DM * DFF; w.K = DM; w.N = DFF; w.WT = (bf16*)((unsigned char*)F_moe13T + (size_t)e * 2 * DFF * DM); w.kind = 2; w.f8 = 1; }
        else if ((r -= I_13) < I_13) { w.W = FIN(IN_MOE3) + (size_t)e * DM * DFF; w.K = DM; w.N = DFF; w.WT = (bf16*)((unsigned char*)F_moe13T + (size_t)e * 2 * DFF * DM); w.kind = 3; w.f8 = 1; }
        else { r -= I_13; w.W = FIN(IN_MOE2) + (size_t)e * DFF * DM; w.K = DFF; w.N = DM; w.WT = (bf16*)((unsigned char*)F_moe2T + (size_t)e * DM * DFF); w.kind = 0; w.f8 = 1; } }
    const int nblk = w.N / 64; w.k0 = 64 * (r / nblk); w.n0 = 64 * (r % nblk); return true;
}
#define WLOAD(R, WI_) do { const float* _p = (WI_).W + (size_t)((WI_).k0 + (lane >> 4)) * (WI_).N + (WI_).n0 + 4 * (lane & 15); \
    _Pragma("unroll") for (int _i = 0; _i < 16; ++_i) R[_i] = *(const f32x4*)(_p + (size_t)(4 * _i) * (WI_).N); } while (0)
#define WSTORE(R, WI_) do { \
    _Pragma("unroll") for (int _i = 0; _i < 16; ++_i) { LAS float* _d = scr + (4 * _i + (lane >> 4)) * 65 + 4 * (lane & 15); _d[0] = R[_i].x; _d[1] = R[_i].y; _d[2] = R[_i].z; _d[3] = R[_i].w; } \
    LDS_WAIT(); asm volatile("" ::: "memory"); \
    _Pragma("unroll") for (int _j = 0; _j < 8; ++_j) { const int _n = (lane >> 3) + 8 * _j; const LAS float* _s = scr + (8 * (lane & 7)) * 65 + _n; \
        if ((WI_).f8) { int _p0 = 0, _p1 = 0; _p0 = __builtin_amdgcn_cvt_pk_fp8_f32(_s[0 * 65] * 64.f, _s[1 * 65] * 64.f, _p0, false); _p0 = __builtin_amdgcn_cvt_pk_fp8_f32(_s[2 * 65] * 64.f, _s[3 * 65] * 64.f, _p0, true); \
            _p1 = __builtin_amdgcn_cvt_pk_fp8_f32(_s[4 * 65] * 64.f, _s[5 * 65] * 64.f, _p1, false); _p1 = __builtin_amdgcn_cvt_pk_fp8_f32(_s[6 * 65] * 64.f, _s[7 * 65] * 64.f, _p1, true); \
            *(v2u*)((unsigned char*)(WI_).WT + (size_t)dst_row_of((WI_).kind, (WI_).n0 + _n) * (WI_).K + (WI_).k0 + 8 * (lane & 7)) = (v2u){(unsigned)_p0, (unsigned)_p1}; } \
        else { v4u _o; _o.x = pk2(_s[0 * 65], _s[1 * 65]); _o.y = pk2(_s[2 * 65], _s[3 * 65]); _o.z = pk2(_s[4 * 65], _s[5 * 65]); _o.w = pk2(_s[6 * 65], _s[7 * 65]); \
        *(v4u*)((WI_).WT + (size_t)dst_row_of((WI_).kind, (WI_).n0 + _n) * (WI_).K + (WI_).k0 + 8 * (lane & 7)) = _o; } } \
    LDS_WAIT(); asm volatile("" ::: "memory"); } while (0)
__device__ __forceinline__ void p0_weights(Frame& F) {
    LAS float* scr = (LAS float*)(F.lds + F.wave * 16640);
    constexpr int I_IN = (DM / 64) * (INW / 64), I_OUT = (DM / 64) * (DM / 64), I_13 = (DM / 64) * (DFF / 64), I_2 = (DFF / 64) * (DM / 64);
    constexpr int NIT = 2 * I_IN + 2 * I_OUT + 2 * I_13 + I_2 + NEXP * (2 * I_13 + I_2), SPLIT = (NIT / 8) * 3;
    const bool late = F.bid < PB; const int lane = F.lane, nb = late ? PB : F.G - PB, NGW = nb * NWAVES, gw = (late ? F.bid : F.bid - PB) * NWAVES + F.wave;
    const int lim = (late && F.G > PB) ? SPLIT : NIT;
    f32x4 ra[16], rb[16]; WItem wa, wb;
    __syncthreads();
    int it = (late ? 0 : SPLIT) + gw; bool va = it < lim && witem_decode(F, it, wa), vb;
    if (va) WLOAD(ra, wa);
    while (va) {
        it += NGW; vb = it < lim && witem_decode(F, it, wb); if (vb) WLOAD(rb, wb);
        WSTORE(ra, wa);
        if (!vb) break;
        it += NGW; va = it < lim && witem_decode(F, it, wa); if (va) WLOAD(ra, wa);
        WSTORE(rb, wb);
    }
    __syncthreads();
}
#undef WLOAD
#undef WSTORE
__device__ __forceinline__ void p0_mod(Frame& F) {
    __syncthreads();
    {
        float* sc = (float*)F.ldsg;
        float* red = sc + 5 * DM;
        for (int i = F.tid; i < 5 * DM; i += NTHR) { const int v = i / DM, k = i % DM; const float x = v < 4 ? FIN(IN_C)[v * DM + k] : FIN(IN_CCTX)[k]; sc[i] = silu_f(x); }
        __syncthreads();
        for (int it = F.bid; it < 2 * (MODW / 64); it += PB) {
            const int l = it / (MODW / 64), n0 = (it % (MODW / 64)) * 64;
            const float* W = FIN(IN_WMOD) + (size_t)l * DM * MODW + n0 + F.lane;
            float a0 = 0.f, a1 = 0.f, a2 = 0.f, a3 = 0.f, a4 = 0.f;
            const int kb = F.wave * 256;
#pragma unroll 8
            for (int k = 0; k < 256; ++k) { const float w = W[(size_t)(kb + k) * MODW];
                a0 += sc[0 * DM + kb + k] * w; a1 += sc[1 * DM + kb + k] * w; a2 += sc[2 * DM + kb + k] * w; a3 += sc[3 * DM + kb + k] * w; a4 += sc[4 * DM + kb + k] * w; }
            red[(F.wave * 5 + 0) * 64 + F.lane] = a0; red[(F.wave * 5 + 1) * 64 + F.lane] = a1; red[(F.wave * 5 + 2) * 64 + F.lane] = a2; red[(F.wave * 5 + 3) * 64 + F.lane] = a3; red[(F.wave * 5 + 4) * 64 + F.lane] = a4;
            __syncthreads();
            if (F.tid < 320) { const int v = F.tid / 64, ln = F.tid % 64; float s = 0.f;
#pragma unroll
                for (int w = 0; w < 8; ++w) s += red[(w * 5 + v) * 64 + ln];
                F_mod[((size_t)l * 5 + v) * MODW + n0 + ln] = s + FIN(IN_BMOD)[l * MODW + n0 + ln]; }
            __syncthreads();
        }
    }
}
__device__ __forceinline__ void fill_dft_table(Frame& F);
__device__ __forceinline__ void p0_tables(Frame& F) {
    __syncthreads();
    for (int i = F.bid * NTHR + F.tid; i < 2 * 4 * 128 * 128; i += PB * NTHR) { const int lg = i >> 14, n = (i >> 7) & 127, k = i & 127; ((bf16*)(F.ws + WS_POOLWT))[i] = (bf16)f2bf(FIN(IN_POOLW)[(size_t)lg * 16384 + k * 128 + n]); }
    fill_dft_table(F);
    for (int i = F.bid * NTHR + F.tid; i < 128 * 32; i += PB * NTHR) {
        const int pos = i >> 5, fi = i & 31; const double inv = pow(10000.0, -(double)fi / 32.0), ang = (double)pos * inv;
        F_ropec[i] = (float)cos(ang); F_ropes[i] = (float)sin(ang);
    }
    for (int i = F.bid * NTHR + F.tid; i < 16384; i += PB * NTHR) { const double ang = 6.283185307179586476925 * (double)i / 16384.0; ((f32x2*)(F.ws + WS_TW))[i] = (f32x2){(float)cos(ang), -(float)sin(ang)}; }
    {
        float* zl = (float*)F.ldsg;
        float* a1l = zl + 8 * 40;
        constexpr int NITEM = (8192 + 8192 + 256) / 8;
        for (int it = F.bid; it < NITEM; it += PB) {
            int set, m0; if (it < 1024) { set = 0; m0 = it * 8; } else if (it < 2048) { set = 1; m0 = (it - 1024) * 8; } else { set = 2; m0 = (it - 2048) * 8; }
            const int l = set == 1 ? 1 : 0, L = set == 2 ? 256 : 8192;
            __syncthreads();
            if (F.tid < 8 * 33) { const int mi = F.tid / 33, k = F.tid % 33, m = m0 + mi; float v;
                if (k == 0) v = (float)m / (float)(L - 1);
                else { const int fi = (k - 1) & 15; const double f = 1e-4 + (double)fi * ((15.0 - 1e-4) / 15.0), w = 6.283185307179586476925 * (double)m / (double)L;
                    v = k <= 16 ? (float)cos(w * f) : -(float)sin(w * f); }
                zl[mi * 40 + k] = v; }
            __syncthreads();
            const int mi = F.tid >> 6, j = F.tid & 63;
            { const float* w1 = FIN(IN_FW1) + l * 33 * 64; float s = FIN(IN_FB1)[l * 64 + j];
#pragma unroll
              for (int k = 0; k < 33; ++k) s += zl[mi * 40 + k] * w1[k * 64 + j];
              a1l[mi * 64 + j] = sinf(FIN(IN_FFREQ)[l * 64 + j] * s); }
            __syncthreads();
            { const float* w2 = FIN(IN_FW2) + l * 64 * 64; float s = FIN(IN_FB2)[l * 64 + j];
#pragma unroll 8
              for (int k = 0; k < 64; ++k) s += a1l[mi * 64 + k] * w2[k * 64 + j];
              float* dst = set == 2 ? F_a2c : F_a2 + (size_t)set * 8192 * 64;
              const float av = sinf(FIN(IN_FFREQ)[l * 64 + j] * s); dst[(size_t)j * L + (m0 + mi)] = av;
              if (set < 2) ((bf16*)(F.ws + WS_A2B))[((size_t)set * 8192 + (m0 + mi)) * 64 + j] = (bf16)f2bf(av); }
        }
    }
}

__device__ __forceinline__ void ctx_kv_tile(Frame& F, int j);
constexpr int CTXKV_WGS = 8;
template <int WHICH, bool ROUTE, bool CTXKV = false>
__device__ __forceinline__ void norm_phase(Frame& F, int layer, int nrows) {
    const float* gvec = FIN(WHICH == 0 ? IN_N1G : IN_N2G) + layer * DM;
    bf16* hbuf = uni_h(F);
    float* rwT = (float*)F.ldsg;
    LAS int* cnt = (LAS int*)(F.lds + 65536);
    if (ROUTE) { __syncthreads(); const float* rw = FIN(IN_ROUTER); for (int i = F.tid; i < DM * 8; i += NTHR) rwT[(i & 7) * DM + (i >> 3)] = rw[i]; __syncthreads(); }
    const int ngroups = ROUTE ? nrows / 128 : 1;
    for (int g = ROUTE ? F.bid : 0; g < ngroups; g += ROUTE ? F.G : 1) {
        if (ROUTE) { __syncthreads(); if (F.tid < 8) cnt[F.tid] = 0; __syncthreads(); }
        int rowb, nr;
        if (ROUTE) { rowb = g * 128 + F.wave * 16; nr = 16; }
        else if (CTXKV && F.G >= 32) {
            if (F.bid >= F.G - CTXKV_WGS) { rowb = NLAT + 256 * ((F.bid - (F.G - CTXKV_WGS)) >> 1) + 32 * F.wave; nr = 32; }
            else { const int NW = (F.G - CTXKV_WGS) * NWAVES, gw = F.bid * NWAVES + F.wave, q = NLAT / NW, rem = NLAT - q * NW; rowb = gw * q + (gw < rem ? gw : rem); nr = q + (gw < rem ? 1 : 0); } }
        else { const int NW = F.G * NWAVES, gw = F.bid * NWAVES + F.wave, q = nrows / NW, rem = nrows - q * NW; rowb = gw * q + (gw < rem ? gw : rem); nr = q + (gw < rem ? 1 : 0); }
        int cur = mod_idx(rowb);
        f32x4 ca[8], cb[8];
#define NCOL(k) (512 * ((k) >> 1) + 8 * F.lane + 4 * ((k) & 1))
#define NORM_LOADMOD(MI_) do { const float* mv = F_mod + ((size_t)layer * 5 + (MI_)) * MODW + (WHICH == 0 ? 0 : 3 * DM);     \
        _Pragma("unroll") for (int k = 0; k < 8; ++k) { const int c = NCOL(k); ca[k] = *(const f32x4*)(gvec + c) * (1.0f + *(const f32x4*)(mv + DM + c)); cb[k] = *(const f32x4*)(mv + c); } } while (0)
        NORM_LOADMOD(cur);
        f32x4 nx[8];
        const bool in32 = WHICH == 0 && layer == 0;
#define NORM_LOADROW(R_) do { if (in32) { const float* xr = xsrc_row(F, 0, (R_)); _Pragma("unroll") for (int k = 0; k < 8; ++k) nx[k] = *(const f32x4*)(xr + NCOL(k)); } \
        else { const bf16* xr = F_x16 + (size_t)(R_) * DM; _Pragma("unroll") for (int j = 0; j < 4; ++j) { const v4u p = *(const v4u*)(xr + 512 * j + 8 * F.lane); \
            nx[2 * j] = (f32x4){__uint_as_float(p.x << 16), __uint_as_float(p.x & 0xffff0000u), __uint_as_float(p.y << 16), __uint_as_float(p.y & 0xffff0000u)}; \
            nx[2 * j + 1] = (f32x4){__uint_as_float(p.z << 16), __uint_as_float(p.z & 0xffff0000u), __uint_as_float(p.w << 16), __uint_as_float(p.w & 0xffff0000u)}; } } } while (0)
        const bool deep = CTXKV && F.G >= 32 && F.bid >= F.G - CTXKV_WGS;
        if (deep) {
            auto body = [&](f32x4 (&v)[8], const int row) __attribute__((always_inline)) {
            float ss = 0.f;
#pragma unroll
            for (int j = 0; j < 8; ++j) ss += (v[j].x * v[j].x + v[j].y * v[j].y) + (v[j].z * v[j].z + v[j].w * v[j].w);
            const float rs = rsqrtf(wave_sum(ss) * (1.0f / DM) + EPS);
#pragma unroll
            for (int j = 0; j < 4; ++j) { const int c = 512 * j + 8 * F.lane;
                const f32x4 y0 = v[2 * j] * rs * ca[2 * j] + cb[2 * j], y1 = v[2 * j + 1] * rs * ca[2 * j + 1] + cb[2 * j + 1]; v[2 * j] = y0; v[2 * j + 1] = y1;
                if (WHICH == 1) { int p0 = 0, p1 = 0; p0 = __builtin_amdgcn_cvt_pk_fp8_f32(y0.x, y0.y, p0, false); p0 = __builtin_amdgcn_cvt_pk_fp8_f32(y0.z, y0.w, p0, true);
                    p1 = __builtin_amdgcn_cvt_pk_fp8_f32(y1.x, y1.y, p1, false); p1 = __builtin_amdgcn_cvt_pk_fp8_f32(y1.z, y1.w, p1, true);
                    *(v2u*)((unsigned char*)hbuf + (size_t)row * DM + c) = (v2u){(unsigned)p0, (unsigned)p1}; }
                else { v4u o; o.x = pk2(y0.x, y0.y); o.y = pk2(y0.z, y0.w); o.z = pk2(y1.x, y1.y); o.w = pk2(y1.z, y1.w);
                *(v4u*)(hbuf + (size_t)row * DM + c) = o; } }
            if (ROUTE) {
                float v0 = -3.0e38f, v1 = -3.0e38f; int i0 = 0, i1 = 0;
#pragma unroll 1
                for (int e = 0; e < 8; ++e) { float sacc = 0.f;
#pragma unroll
                    for (int j = 0; j < 8; ++j) { const f32x4 w = *(const f32x4*)(rwT + e * DM + NCOL(j)); sacc += (v[j].x * w.x + v[j].y * w.y) + (v[j].z * w.z + v[j].w * w.w); }
                    const float lg = wave_sum(sacc);
                    if (lg > v0) { v1 = v0; i1 = i0; v0 = lg; i0 = e; } else if (lg > v1) { v1 = lg; i1 = e; } }
                if (F.lane == 0) {
                    const float w1 = 1.0f / (1.0f + __expf(v0 - v1)), w0 = 1.0f - w1;
                    F_top_e[row * 2 + 0] = i0; F_top_e[row * 2 + 1] = i1; F_gatew[row * 2 + 0] = w0; F_gatew[row * 2 + 1] = w1;
                    atomicAdd((int*)&cnt[i0], 1); atomicAdd((int*)&cnt[i1], 1);
                }
            }
            };
            v4u p0[4], p1[4], p2[4], p3[4];
#define NORM_LOADRAW(P_, R_) do { const bf16* xr = F_x16 + (size_t)(R_) * DM; _Pragma("unroll") for (int j = 0; j < 4; ++j) P_[j] = *(const v4u*)(xr + 512 * j + 8 * F.lane); } while (0)
#define NORM_STEP(P_, K_) if (r + (K_) < nr) { const int row = rowb + r + (K_); f32x4 v[8]; \
            _Pragma("unroll") for (int j = 0; j < 4; ++j) { const v4u p = P_[j]; \
                v[2 * j] = (f32x4){__uint_as_float(p.x << 16), __uint_as_float(p.x & 0xffff0000u), __uint_as_float(p.y << 16), __uint_as_float(p.y & 0xffff0000u)}; \
                v[2 * j + 1] = (f32x4){__uint_as_float(p.z << 16), __uint_as_float(p.z & 0xffff0000u), __uint_as_float(p.w << 16), __uint_as_float(p.w & 0xffff0000u)}; } \
            if (r + (K_) + 4 < nr) NORM_LOADRAW(P_, row + 4); \
            body(v, row); }
            if (nr > 0) NORM_LOADRAW(p0, rowb); if (nr > 1) NORM_LOADRAW(p1, rowb + 1); if (nr > 2) NORM_LOADRAW(p2, rowb + 2); if (nr > 3) NORM_LOADRAW(p3, rowb + 3);
#pragma unroll 1
            for (int r = 0; r < nr; r += 4) { NORM_STEP(p0, 0) NORM_STEP(p1, 1) NORM_STEP(p2, 2) NORM_STEP(p3, 3) }
#undef NORM_STEP
#undef NORM_LOADRAW
        } else {
        if (nr > 0) NORM_LOADROW(rowb);
#pragma unroll 1
        for (int r = 0; r < nr; ++r) {
            const int row = rowb + r;
            if (!ROUTE) { const int mi = mod_idx(row); if (mi != cur) { cur = mi; NORM_LOADMOD(cur); } }
            f32x4 v[8]; float ss = 0.f;
#pragma unroll
            for (int j = 0; j < 8; ++j) { v[j] = nx[j]; ss += (v[j].x * v[j].x + v[j].y * v[j].y) + (v[j].z * v[j].z + v[j].w * v[j].w); }
            if (r + 1 < nr) NORM_LOADROW(row + 1);
            const float rs = rsqrtf(wave_sum(ss) * (1.0f / DM) + EPS);
#pragma unroll
            for (int j = 0; j < 4; ++j) { const int c = 512 * j + 8 * F.lane;
                const f32x4 y0 = v[2 * j] * rs * ca[2 * j] + cb[2 * j], y1 = v[2 * j + 1] * rs * ca[2 * j + 1] + cb[2 * j + 1]; v[2 * j] = y0; v[2 * j + 1] = y1;
                if (WHICH == 1) { int p0 = 0, p1 = 0; p0 = __builtin_amdgcn_cvt_pk_fp8_f32(y0.x, y0.y, p0, false); p0 = __builtin_amdgcn_cvt_pk_fp8_f32(y0.z, y0.w, p0, true);
                    p1 = __builtin_amdgcn_cvt_pk_fp8_f32(y1.x, y1.y, p1, false); p1 = __builtin_amdgcn_cvt_pk_fp8_f32(y1.z, y1.w, p1, true);
                    *(v2u*)((unsigned char*)hbuf + (size_t)row * DM + c) = (v2u){(unsigned)p0, (unsigned)p1}; }
                else { v4u o; o.x = pk2(y0.x, y0.y); o.y = pk2(y0.z, y0.w); o.z = pk2(y1.x, y1.y); o.w = pk2(y1.z, y1.w);
                *(v4u*)(hbuf + (size_t)row * DM + c) = o; } }
            if (ROUTE) {
                float v0 = -3.0e38f, v1 = -3.0e38f; int i0 = 0, i1 = 0;
#pragma unroll 1
                for (int e = 0; e < 8; ++e) { float sacc = 0.f;
#pragma unroll
                    for (int j = 0; j < 8; ++j) { const f32x4 w = *(const f32x4*)(rwT + e * DM + NCOL(j)); sacc += (v[j].x * w.x + v[j].y * w.y) + (v[j].z * w.z + v[j].w * w.w); }
                    const float lg = wave_sum(sacc);
                    if (lg > v0) { v1 = v0; i1 = i0; v0 = lg; i0 = e; } else if (lg > v1) { v1 = lg; i1 = e; } }
                if (F.lane == 0) {
                    const float w1 = 1.0f / (1.0f + __expf(v0 - v1)), w0 = 1.0f - w1;
                    F_top_e[row * 2 + 0] = i0; F_top_e[row * 2 + 1] = i1; F_gatew[row * 2 + 0] = w0; F_gatew[row * 2 + 1] = w1;
                    atomicAdd((int*)&cnt[i0], 1); atomicAdd((int*)&cnt[i1], 1);
                }
            }
        }
        }
        if (ROUTE) { __syncthreads(); if (F.tid < 8) F_grpcnt[g * 8 + F.tid] = cnt[F.tid]; }
        if (CTXKV && F.G >= 32 && F.bid >= F.G - CTXKV_WGS) { asm volatile("s_waitcnt vmcnt(0)" ::: "memory"); __syncthreads(); ctx_kv_tile(F, F.bid - (F.G - CTXKV_WGS)); }
    }
#undef NORM_LOADROW
#undef NORM_LOADMOD
#undef NCOL
}

using pg8::Unit;
struct WinOrder {
    pg8::StaticOrder so; int G, c, tokp0, wp0, N0, N1;
    __device__ void init(int G_, int c_, int layer) { const int mp = (layer == 1 && G_ >= 32) ? NLAT / 256 : MTOT / 256; so.init(mp * 256, QKVP, G_, c_); G = G_; c = c_; tokp0 = layer == 0 ? INW / 256 : 0; wp0 = layer == 0 ? 0 : MTOT / 256;
        N0 = mp * (QKVP / 256); N1 = (HYP / 256) * mp; }
    __device__ bool next(int i, Unit& u) const {
        const int L = i * G + c;
        if (L < N0) { int pm, pn; so.map(L, pm, pn); u.pm = tokp0 + pm; u.pn = wp0 + pn; u.orow = pm * 256; u.ocol = pn * 256; u.kind = 0; return true; }
        if (L < N0 + N1) { const int s = L - N0, tt = s / (HYP / 256), cp = s % (HYP / 256); u.pm = wp0 + QKVP / 256 + cp; u.pn = tokp0 + tt; u.orow = cp * 256; u.ocol = tt * 256; u.kind = 1; return true; }
        return false;
    }
    __device__ __forceinline__ void a_ready(const Unit&) const {}
    __device__ __forceinline__ void done(const Unit&) const {}
};
struct EpiIn {
    static constexpr bool PERM = true;
    bf16* proj; bf16* hyT; const float* ropec; const float* ropes;
    __device__ __forceinline__ void operator()(pg8::f32x4 (&acc)[2][2][4][2], const Unit& u, int wr, int wc, int fr, int fq) const {
        const bool tr = u.kind != 0; bf16* base = tr ? hyT : proj; const int ldc = tr ? MTOT : QKVP;
        const int row0 = u.orow + wr * 64 + fr, col0 = u.ocol + wc * 32 + 8 * fq;
        const bool qk = !tr && u.ocol < 1280; const float qs = (!tr && u.ocol < 1024) ? 0.088388347648318440f : 1.0f;
        const int g = 4 * wc + fq, hf = g >> 3, i0 = (g & 7) * 4;
        f32x4 cs[8], sn[8];
#pragma unroll
        for (int q = 0; q < 8; ++q) { const int row = row0 + (q >> 2) * 128 + (q & 3) * 16; cs[q] = (f32x4){1.f, 1.f, 1.f, 1.f}; sn[q] = (f32x4){0.f, 0.f, 0.f, 0.f};
            if (qk && row < NLAT) { const int t = row & (SEQ - 1), pos = hf ? (t & 63) : (t >> 6); cs[q] = *(const f32x4*)(ropec + pos * 32 + i0); sn[q] = *(const f32x4*)(ropes + pos * 32 + i0); } }
#pragma unroll
        for (int ai = 0; ai < 2; ++ai)
#pragma unroll
            for (int m = 0; m < 4; ++m) { const int row = row0 + ai * 128 + m * 16; bf16* rowp = base + (size_t)row * ldc + col0;
#pragma unroll
                for (int bj = 0; bj < 2; ++bj) { f32x4 v0 = acc[ai][bj][m][0], v1 = acc[ai][bj][m][1];
                    if (qk) { const f32x4 y0 = (v0 * cs[ai * 4 + m] - v1 * sn[ai * 4 + m]) * qs, y1 = (v1 * cs[ai * 4 + m] + v0 * sn[ai * 4 + m]) * qs; v0 = y0; v1 = y1; }
                    v4u w; w.x = pg8::cvt_pk_bf16(v0[0], v0[1]); w.y = pg8::cvt_pk_bf16(v0[2], v0[3]); w.z = pg8::cvt_pk_bf16(v1[0], v1[1]); w.w = pg8::cvt_pk_bf16(v1[2], v1[3]);
                    *(v4u*)(rowp + bj * 128) = w; } }
    }
};
struct OneTile { Unit u0;
    __device__ bool next(int i, Unit& u) const { if (i != 0) return false; u = u0; return true; }
    __device__ __forceinline__ void a_ready(const Unit&) const {}
    __device__ __forceinline__ void done(const Unit&) const {}
};
__device__ __forceinline__ void ctx_kv_tile(Frame& F, int j) {
    pg8::Gemm g{uni_h(F), uni_h(F), DM};
    OneTile S; const int pm = NLAT / 256 + (j >> 1), pn = 4 + (j & 1);
    S.u0.pm = pm; S.u0.pn = MTOT / 256 + pn; S.u0.orow = pm * 256; S.u0.ocol = pn * 256; S.u0.kind = 0;
    EpiIn E{F_proj, F_hyT, F_ropec, F_ropes};
    pg8::gemm_phase<EpiIn, OneTile, true, true>(F.lds, g, S, E, F.tid);
}
template <bool SRC32> struct EpiResid {
    static constexpr bool PERM = false;
    const float* lat_old; const float* ctx_old; bf16* x16; const float* gate; float asc;
    __device__ __forceinline__ void operator()(pg8::f32x4 (&acc)[2][2][4][2], const Unit& u, int wr, int wc, int fr, int fq) const {
        const int row0 = u.orow + wr * 64 + fr, col0 = u.ocol + wc * 32 + 4 * fq;
        const bool cx = u.orow >= NLAT;
        const float* src0 = cx ? ctx_old + (size_t)(row0 - NLAT) * DM : lat_old + (size_t)row0 * DM; bf16* dst0 = x16 + (size_t)row0 * DM;
        const float* gp = gate + (size_t)(cx ? 4 : (u.orow >> 13)) * MODW + col0;
        f32x4 gv[2][2];
#pragma unroll
        for (int bj = 0; bj < 2; ++bj)
#pragma unroll
            for (int n = 0; n < 2; ++n) gv[bj][n] = *(const f32x4*)(gp + bj * 128 + n * 16) * asc;
#pragma unroll
        for (int ai = 0; ai < 2; ++ai) {
            f32x4 xo[4][2][2];
#pragma unroll
            for (int m = 0; m < 4; ++m)
#pragma unroll
                for (int bj = 0; bj < 2; ++bj)
#pragma unroll
                    for (int n = 0; n < 2; ++n) { const size_t o = (size_t)(ai * 128 + m * 16) * DM + col0 + bj * 128 + n * 16;
                        if (SRC32) xo[m][bj][n] = *(const f32x4*)(src0 + o);
                        else { const v2u p = *(const v2u*)(dst0 + o); xo[m][bj][n] = (f32x4){__uint_as_float(p.x << 16), __uint_as_float(p.x & 0xffff0000u), __uint_as_float(p.y << 16), __uint_as_float(p.y & 0xffff0000u)}; } }
#pragma unroll
            for (int m = 0; m < 4; ++m)
#pragma unroll
                for (int bj = 0; bj < 2; ++bj)
#pragma unroll
                    for (int n = 0; n < 2; ++n) { const f32x4 y = xo[m][bj][n] + gv[bj][n] * acc[ai][bj][m][n];
                        *(v2u*)(dst0 + (size_t)(ai * 128 + m * 16) * DM + col0 + bj * 128 + n * 16) = (v2u){pg8::cvt_pk_bf16(y[0], y[1]), pg8::cvt_pk_bf16(y[2], y[3])}; }
            asm volatile("" ::: "memory"); }
    }
};
struct EpiSwiglu {
    static constexpr bool PERM = true;
    bf16* H; float wscale; int f8out;
    __device__ __forceinline__ void operator()(pg8::f32x4 (&acc)[2][2][4][2], const Unit& u, int wr, int wc, int fr, int fq) const {
        const int row0 = u.orow + wr * 64 + fr, col0 = (u.ocol >> 1) + wc * 32 + 8 * fq;
#pragma unroll
        for (int ai = 0; ai < 2; ++ai)
#pragma unroll
            for (int m = 0; m < 4; ++m) { bf16* rowp = H + (size_t)(row0 + ai * 128 + m * 16) * DFF + col0;
                float o[8];
#pragma unroll
                for (int n = 0; n < 2; ++n)
#pragma unroll
                    for (int j = 0; j < 4; ++j) { const float gt = acc[ai][0][m][n][j] * wscale, up = acc[ai][1][m][n][j] * wscale; o[n * 4 + j] = gt * __builtin_amdgcn_rcpf(1.0f + __expf(-gt)) * up; }
                if (f8out) { int p0 = 0, p1 = 0; p0 = __builtin_amdgcn_cvt_pk_fp8_f32(o[0], o[1], p0, false); p0 = __builtin_amdgcn_cvt_pk_fp8_f32(o[2], o[3], p0, true); p1 = __builtin_amdgcn_cvt_pk_fp8_f32(o[4], o[5], p1, false); p1 = __builtin_amdgcn_cvt_pk_fp8_f32(o[6], o[7], p1, true);
                    *(v2u*)((unsigned char*)H + (size_t)(row0 + ai * 128 + m * 16) * DFF + col0) = (v2u){(unsigned)p0, (unsigned)p1}; }
                else { v4u w; w.x = pg8::cvt_pk_bf16(o[0], o[1]); w.y = pg8::cvt_pk_bf16(o[2], o[3]); w.z = pg8::cvt_pk_bf16(o[4], o[5]); w.w = pg8::cvt_pk_bf16(o[6], o[7]);
                *(v4u*)rowp = w; } }
    }
};
struct EpiBf16Plain {
    static constexpr bool PERM = true;
    bf16* O; int ldc; float sc;
    __device__ __forceinline__ void operator()(pg8::f32x4 (&acc)[2][2][4][2], const Unit& u, int wr, int wc, int fr, int fq) const {
        const int row0 = u.orow + wr * 64 + fr, col0 = u.ocol + wc * 32 + 8 * fq;
#pragma unroll
        for (int ai = 0; ai < 2; ++ai)
#pragma unroll
            for (int m = 0; m < 4; ++m) { bf16* rowp = O + (size_t)(row0 + ai * 128 + m * 16) * ldc + col0;
#pragma unroll
                for (int bj = 0; bj < 2; ++bj) { const f32x4 v0 = acc[ai][bj][m][0] * sc, v1 = acc[ai][bj][m][1] * sc;
                    v4u w; w.x = pg8::cvt_pk_bf16(v0[0], v0[1]); w.y = pg8::cvt_pk_bf16(v0[2], v0[3]); w.z = pg8::cvt_pk_bf16(v1[0], v1[1]); w.w = pg8::cvt_pk_bf16(v1[2], v1[3]);
                    *(v4u*)(rowp + bj * 128) = w; } }
    }
};
struct MoeOrder {
    int G, c, p_lo, np, nN, a_off, o_off; const int* ps;
    __device__ bool next(int i, Unit& u) const {
        const int L = i * G + c; if (L >= np * nN) return false;
        const int nig = 8 * nN, gid = L / nig, fm = gid * 8, gsz = (np - fm) < 8 ? (np - fm) : 8, lp = fm + (L % nig) % gsz, j = (L % nig) / gsz;
        const int p = p_lo + lp; int e = 0;
#pragma unroll
        for (int q = 1; q < 8; ++q) e += (p >= ps[q]) ? 1 : 0;
        u.pm = p - a_off; u.pn = e * nN + j; u.orow = (p - o_off) * 256; u.ocol = j * 256; u.kind = e; return true;
    }
    __device__ __forceinline__ void a_ready(const Unit&) const {}
    __device__ __forceinline__ void done(const Unit&) const {}
};

__device__ __forceinline__ float hy_short(const bf16* row, int t, int L, float w0, float w1, float w2, float bb) {
    const float um = t > 0 ? bf2f(row[t - 1]) : 0.f, u0 = bf2f(row[t]), up = t < L - 1 ? bf2f(row[t + 1]) : 0.f;
    return w0 * um + w1 * u0 + w2 * up + bb;
}
__device__ __forceinline__ void pool_unit(Frame& F, int layer, int tile, int g) {
    typedef short bf16x8v __attribute__((ext_vector_type(8)));
    typedef float f32x16v __attribute__((ext_vector_type(16)));
    constexpr int PITCH = 272;
    char* Ul = (char*)F.ldsg;
    char* Dl = Ul + 144 * 256;
    char* Wl = Dl + 128 * PITCH;
    const int row0 = tile * 128; const bool cx = row0 >= NLAT; const int L = cx ? CTXL : SEQ;
    const int seq0 = cx ? NLAT + ((row0 - NLAT) / CTXL) * CTXL : (row0 / SEQ) * SEQ, t0 = row0 - seq0;
    const int win = 2 << g, tid = F.tid;
    __syncthreads();
    for (int i = tid; i < 144 * 16; i += NTHR) { const int r = i >> 4, ch = i & 15, t = t0 - 8 + r; v4u v = (v4u){0u, 0u, 0u, 0u};
        if (t >= 0 && t < L) v = *(const v4u*)(F_proj + (size_t)(seq0 + t) * QKVP + 1536 + g * 128 + ch * 8);
        *(v4u*)(Ul + r * 256 + ch * 16) = v; }
    { const bf16* wt = (const bf16*)(F.ws + WS_POOLWT) + (size_t)(layer * 4 + g) * 16384;
      for (int i = tid; i < 128 * 16; i += NTHR) { const int n = i >> 4, ch = i & 15; *(v4u*)(Wl + n * PITCH + ch * 16) = *(const v4u*)(wt + n * 128 + ch * 8); } }
    __syncthreads();
    { const int tt = tid >> 2, cb = (tid & 3) * 32, t = t0 + tt; int lo = t - win / 2, hi = t + win - win / 2; lo = lo < 0 ? 0 : lo; hi = hi > L ? L : hi;
      const float inv = 1.0f / (float)(hi - lo);
#pragma unroll
      for (int q = 0; q < 4; ++q) { float s[8];
#pragma unroll
          for (int k = 0; k < 8; ++k) s[k] = 0.f;
          for (int r = lo; r < hi; ++r) { const v4u v = *(const v4u*)(Ul + (r - t0 + 8) * 256 + (cb + 8 * q) * 2);
              s[0] += __uint_as_float(v.x << 16); s[1] += __uint_as_float(v.x & 0xffff0000u); s[2] += __uint_as_float(v.y << 16); s[3] += __uint_as_float(v.y & 0xffff0000u);
              s[4] += __uint_as_float(v.z << 16); s[5] += __uint_as_float(v.z & 0xffff0000u); s[6] += __uint_as_float(v.w << 16); s[7] += __uint_as_float(v.w & 0xffff0000u); }
          const v4u c = *(const v4u*)(Ul + (tt + 8) * 256 + (cb + 8 * q) * 2);
          v4u o; o.x = pk2(s[0] * inv - __uint_as_float(c.x << 16), s[1] * inv - __uint_as_float(c.x & 0xffff0000u)); o.y = pk2(s[2] * inv - __uint_as_float(c.y << 16), s[3] * inv - __uint_as_float(c.y & 0xffff0000u));
          o.z = pk2(s[4] * inv - __uint_as_float(c.z << 16), s[5] * inv - __uint_as_float(c.z & 0xffff0000u)); o.w = pk2(s[6] * inv - __uint_as_float(c.w << 16), s[7] * inv - __uint_as_float(c.w & 0xffff0000u));
          *(v4u*)(Dl + tt * PITCH + (cb + 8 * q) * 2) = o; } }
    __syncthreads();
    { const int w = F.wave, lane = F.lane, r32 = lane & 31, hi = lane >> 5, mt = w & 3, nh = w >> 2;
      f32x16v acc0 = {}, acc1 = {};
#pragma unroll
      for (int ks = 0; ks < 8; ++ks) { const int kb = (16 * ks + 8 * hi) * 2;
          const bf16x8v a = *(const bf16x8v*)(Dl + (32 * mt + r32) * PITCH + kb);
          const bf16x8v b0 = *(const bf16x8v*)(Wl + (64 * nh + r32) * PITCH + kb), b1 = *(const bf16x8v*)(Wl + (64 * nh + 32 + r32) * PITCH + kb);
          acc0 = __builtin_amdgcn_mfma_f32_32x32x16_bf16(a, b0, acc0, 0, 0, 0); acc1 = __builtin_amdgcn_mfma_f32_32x32x16_bf16(a, b1, acc1, 0, 0, 0); }
      const float* ps = FIN(IN_POOLS) + layer * POOLW + g * 128 + 64 * nh; const float s0 = ps[r32], s1 = ps[32 + r32];
      bf16* op = (bf16*)F_pool + (size_t)(row0 + 32 * mt) * POOLW + g * 128 + 64 * nh + r32;
#pragma unroll
      for (int r = 0; r < 16; ++r) { const int m = (r & 3) + 8 * (r >> 2) + 4 * hi; op[(size_t)m * POOLW] = (bf16)f2bf(acc0[r] * s0); op[(size_t)m * POOLW + 32] = (bf16)f2bf(acc1[r] * s1); } }
}
template <int L>
__device__ __forceinline__ void hyena_unit(Frame& F, int layer, int seq0, int c) {
    float* zb = (float*)F.ldsg; float* zn = zb + L; float* H = zn + L;
    float* w3s = H + 2 * L + 32;
    const float* a2 = L == SEQ ? F_a2 + (size_t)layer * SEQ * 64 : F_a2c;
    const float* cw = FIN(IN_HCW) + layer * 3 * HYP; const float* cb = FIN(IN_HCB) + layer * HYP;
    const bf16* vrow = F_hyT + (size_t)c * MTOT + seq0;
    const float mind = -4.605170185988091f / 1.5f, maxd = -4.605170185988091f / 0.3f;
    const float adelta = fabsf(mind + (float)c * ((maxd - mind) / 511.0f));
    __syncthreads();
    { const float w0 = cw[c], w1 = cw[HYP + c], w2 = cw[2 * HYP + c], bb = cb[c];
      for (int t = F.tid; t < L; t += NTHR) zb[t] = hy_short(vrow, t, L, w0, w1, w2, bb); }
#pragma unroll
    for (int o = 0; o < 2; ++o) {
        float* zin = o == 0 ? zb : zn; float* zout = o == 0 ? zn : zb;
        const int jf = o * 1024 + c, jb = o * 1024 + 512 + c;
        if (F.tid < 64) w3s[F.tid] = FIN(IN_FW3)[((size_t)layer * 64 + F.tid) * 2048 + jf];
        else if (F.tid < 128) w3s[F.tid] = FIN(IN_FW3)[((size_t)layer * 64 + (F.tid - 64)) * 2048 + jb];
        if (F.tid < 16) { H[F.tid] = 0.f; H[2 * L + 16 + F.tid] = 0.f; }
        if (F.tid == 16) H[2 * L + 15] = 0.f;
        __syncthreads();
        { const float b3f = FIN(IN_FB3)[layer * 2048 + jf], b3b = FIN(IN_FB3)[layer * 2048 + jb];
          for (int m = F.tid; m < L; m += NTHR) { float sf = 0.f, sb = 0.f;
#pragma unroll
              for (int q = 0; q < 16; ++q) { const f32x4 a = (f32x4){a2[(size_t)(4 * q) * L + m], a2[(size_t)(4 * q + 1) * L + m], a2[(size_t)(4 * q + 2) * L + m], a2[(size_t)(4 * q + 3) * L + m]}; const f32x4 wf = *(const f32x4*)(w3s + 4 * q), wb = *(const f32x4*)(w3s + 64 + 4 * q);
                  sf += (a.x * wf.x + a.y * wf.y) + (a.z * wf.z + a.w * wf.w); sb += (a.x * wb.x + a.y * wb.y) + (a.z * wb.z + a.w * wb.w); }
              const float dec = __expf(-((float)m / (float)(L - 1)) * adelta);
              H[L + 15 + m] = (sf + b3f) * dec; if (m >= 1) H[L + 15 - m] = (sb + b3b) * dec; } }
        __syncthreads();
        const int ch = (o + 1) * HYW + c; const bf16* xrow = F_hyT + (size_t)ch * MTOT + seq0;
        const float w0 = cw[ch], w1 = cw[HYP + ch], w2 = cw[2 * HYP + ch], bb = cb[ch], hb = FIN(IN_HBIAS)[layer * 1024 + o * 512 + c];
        if constexpr (L == SEQ) {
            const int t0 = 16 * F.tid; float acc[16];
#pragma unroll
            for (int i = 0; i < 16; ++i) acc[i] = 0.f;
            for (int s0 = 0; s0 < L; s0 += 16) {
                const float* hp = H + (t0 - s0 + L); float hw[32], zc[16];
#pragma unroll
                for (int q = 0; q < 8; ++q) { const f32x4 v = *(const f32x4*)(hp + 4 * q); hw[4 * q] = v.x; hw[4 * q + 1] = v.y; hw[4 * q + 2] = v.z; hw[4 * q + 3] = v.w; }
#pragma unroll
                for (int q = 0; q < 4; ++q) { const f32x4 v = *(const f32x4*)(zin + s0 + 4 * q); zc[4 * q] = v.x; zc[4 * q + 1] = v.y; zc[4 * q + 2] = v.z; zc[4 * q + 3] = v.w; }
#pragma unroll
                for (int i = 0; i < 16; ++i)
#pragma unroll
                    for (int k = 0; k < 16; ++k) acc[i] += zc[k] * hw[15 + i - k];
            }
#pragma unroll
            for (int i = 0; i < 16; ++i) { const int t = t0 + i; const float xo = hy_short(xrow, t, L, w0, w1, w2, bb); const float zv = xo * (acc[i] + zin[t] * hb);
                if (o == 0) zout[t] = zv; else F_zT[(size_t)c * MTOT + seq0 + t] = zv; }
        } else {
            if (F.tid < L) { const int t = F.tid; float a = 0.f;
                for (int s = 0; s < L; ++s) a += zin[s] * H[t - s + L + 15];
                const float xo = hy_short(xrow, t, L, w0, w1, w2, bb); const float zv = xo * (a + zin[t] * hb);
                if (o == 0) zout[t] = zv; else F_zT[(size_t)c * MTOT + seq0 + t] = zv; }
        }
        __syncthreads();
    }
}
__device__ __forceinline__ unsigned launder_u(unsigned v);
namespace hyf {
constexpr int N = 16384, LQ = 8192;
__device__ __forceinline__ int opq(int v) { asm volatile("" : "+v"(v)); return v; }
__device__ __forceinline__ constexpr float c32(int i) { constexpr float t[16] = {1.000000000e+00f, 9.807852804e-01f, 9.238795325e-01f, 8.314696123e-01f, 7.071067812e-01f, 5.555702330e-01f, 3.826834324e-01f, 1.950903220e-01f,
    0.0f, -1.950903220e-01f, -3.826834324e-01f, -5.555702330e-01f, -7.071067812e-01f, -8.314696123e-01f, -9.238795325e-01f, -9.807852804e-01f}; return t[i]; }
__device__ __forceinline__ constexpr float s32(int i) { constexpr float t[16] = {0.000000000e+00f, 1.950903220e-01f, 3.826834324e-01f, 5.555702330e-01f, 7.071067812e-01f, 8.314696123e-01f, 9.238795325e-01f, 9.807852804e-01f,
    1.000000000e+00f, 9.807852804e-01f, 9.238795325e-01f, 8.314696123e-01f, 7.071067812e-01f, 5.555702330e-01f, 3.826834324e-01f, 1.950903220e-01f}; return t[i]; }
__device__ __forceinline__ constexpr int brev(int i, int bits) { int r = 0; for (int k = 0; k < bits; ++k) r |= ((i >> k) & 1) << (bits - 1 - k); return r; }
template <int R, bool INV> __device__ __forceinline__ void fft_reg(float (&re)[R], float (&im)[R]) {
#pragma unroll
    for (int len = R; len >= 2; len >>= 1) { const int half = len / 2;
#pragma unroll
        for (int blk = 0; blk < R; blk += len)
#pragma unroll
            for (int i = 0; i < half; ++i) { const int p = blk + i, q = p + half;
                const float ur = re[p] + re[q], ui = im[p] + im[q], vr = re[p] - re[q], vi = im[p] - im[q];
                const float c = c32(i * (32 / len)), sn = INV ? s32(i * (32 / len)) : -s32(i * (32 / len));
                re[p] = ur; im[p] = ui; re[q] = vr * c - vi * sn; im[q] = vr * sn + vi * c; } }
}
template <bool INV> __device__ __forceinline__ void tw_build(const f32x2* __restrict__ TW, int e, float (&lr)[8], float (&li)[8], float (&hr)[4], float (&hi)[4]) {
    (void)TW; f32x2 b0, b1, b2, b3, b4; const float sg = INV ? 1.0f : -1.0f;
    { const float x = (float)(e & (N - 1)) * (1.0f / N); b0.x = __builtin_amdgcn_cosf(x); b0.y = sg * __builtin_amdgcn_sinf(x); }
    { const float x = (float)((2 * e) & (N - 1)) * (1.0f / N); b1.x = __builtin_amdgcn_cosf(x); b1.y = sg * __builtin_amdgcn_sinf(x); }
    { const float x = (float)((4 * e) & (N - 1)) * (1.0f / N); b2.x = __builtin_amdgcn_cosf(x); b2.y = sg * __builtin_amdgcn_sinf(x); }
    { const float x = (float)((8 * e) & (N - 1)) * (1.0f / N); b3.x = __builtin_amdgcn_cosf(x); b3.y = sg * __builtin_amdgcn_sinf(x); }
    { const float x = (float)((16 * e) & (N - 1)) * (1.0f / N); b4.x = __builtin_amdgcn_cosf(x); b4.y = sg * __builtin_amdgcn_sinf(x); }
    lr[0] = 1.f; li[0] = 0.f; lr[1] = b0.x; li[1] = b0.y; lr[2] = b1.x; li[2] = b1.y; lr[3] = b0.x * b1.x - b0.y * b1.y; li[3] = b0.x * b1.y + b0.y * b1.x;
    lr[4] = b2.x; li[4] = b2.y; lr[5] = b2.x * b0.x - b2.y * b0.y; li[5] = b2.x * b0.y + b2.y * b0.x; lr[6] = b2.x * b1.x - b2.y * b1.y; li[6] = b2.x * b1.y + b2.y * b1.x;
    lr[7] = b2.x * lr[3] - b2.y * li[3]; li[7] = b2.x * li[3] + b2.y * lr[3];
    hr[0] = 1.f; hi[0] = 0.f; hr[1] = b3.x; hi[1] = b3.y; hr[2] = b4.x; hi[2] = b4.y; hr[3] = b3.x * b4.x - b3.y * b4.y; hi[3] = b3.x * b4.y + b3.y * b4.x;
}
#define HYF_TWMUL(k, xr, xi) do { const int _l = (k) & 7, _h = (k) >> 3; float _wr, _wi; \
    if (_l == 0) { _wr = hr[_h]; _wi = hi[_h]; } else if (_h == 0) { _wr = lr[_l]; _wi = li[_l]; } else { _wr = lr[_l] * hr[_h] - li[_l] * hi[_h]; _wi = lr[_l] * hi[_h] + li[_l] * hr[_h]; } \
    if ((k) != 0) { const float _t = (xr) * _wr - (xi) * _wi; (xi) = (xr) * _wi + (xi) * _wr; (xr) = _t; } } while (0)
__device__ __forceinline__ int phA(int a, int b) { return a + (a >> 4) + 560 * b; }
__device__ __forceinline__ int phB(int kb, int a2, int b2) { return 560 * kb + a2 + 17 * b2; }
__device__ __forceinline__ int phC(int g, int a3) { return 17 * g + 16 * (g >> 5) + a3; }
constexpr int XWORDS = 17920;
__device__ __forceinline__ void passA_fwd(f32x2* X, const f32x2* TW, float (&re)[32], float (&im)[32], int a) {
    fft_reg<32, false>(re, im);
    float lr[8], li[8], hr[4], hi[4]; tw_build<false>(TW, a, lr, li, hr, hi);
#pragma unroll
    for (int i = 0; i < 32; ++i) { const int kb = brev(i, 5); HYF_TWMUL(kb, re[i], im[i]); X[phA(a, kb)] = (f32x2){re[i], im[i]}; }
}
__device__ __forceinline__ void passB_fwd(f32x2* X, const f32x2* TW, int t) {
    const int kb = t >> 4, a2 = t & 15; float re[32], im[32];
#pragma unroll
    for (int b = 0; b < 32; ++b) { const f32x2 v = X[phB(kb, a2, b)]; re[b] = v.x; im[b] = v.y; }
    fft_reg<32, false>(re, im);
    float lr[8], li[8], hr[4], hi[4]; tw_build<false>(TW, 32 * a2, lr, li, hr, hi);
#pragma unroll
    for (int i = 0; i < 32; ++i) { const int k2 = brev(i, 5); HYF_TWMUL(k2, re[i], im[i]); X[phB(kb, a2, k2)] = (f32x2){re[i], im[i]}; }
}
__device__ __forceinline__ void passB_inv(f32x2* X, const f32x2* TW, int t) {
    const int kb = t >> 4, a2 = t & 15; float re[32], im[32];
    float lr[8], li[8], hr[4], hi[4]; tw_build<true>(TW, 32 * a2, lr, li, hr, hi);
#pragma unroll
    for (int k2 = 0; k2 < 32; ++k2) { const f32x2 v = X[phB(kb, a2, k2)]; re[k2] = v.x; im[k2] = v.y; HYF_TWMUL(k2, re[k2], im[k2]); }
    fft_reg<32, true>(re, im);
#pragma unroll
    for (int i = 0; i < 32; ++i) X[phB(kb, a2, brev(i, 5))] = (f32x2){re[i], im[i]};
}
__device__ __forceinline__ void passA_inv(const f32x2* X, const f32x2* TW, float (&re)[32], float (&im)[32], int a) {
    float lr[8], li[8], hr[4], hi[4]; tw_build<true>(TW, a, lr, li, hr, hi);
#pragma unroll
    for (int kb = 0; kb < 32; ++kb) { const f32x2 v = X[phA(a, kb)]; re[kb] = v.x; im[kb] = v.y; HYF_TWMUL(kb, re[kb], im[kb]); }
    fft_reg<32, true>(re, im);
}
__device__ __forceinline__ void passC_filter(const f32x2* X, f32x2* __restrict__ K, int g) {
    float re[16], im[16];
#pragma unroll
    for (int a3 = 0; a3 < 16; ++a3) { const f32x2 v = X[phC(g, a3)]; re[a3] = v.x; im[a3] = v.y; }
    fft_reg<16, false>(re, im);
    float kr[16], ki[16];
#pragma unroll
    for (int i = 0; i < 16; ++i) { kr[brev(i, 4)] = re[i] * (1.0f / N); ki[brev(i, 4)] = im[i] * (1.0f / N); }
#pragma unroll
    for (int q = 0; q < 8; ++q) *(f32x4*)(K + 16 * g + 2 * q) = (f32x4){kr[2 * q], ki[2 * q], kr[2 * q + 1], ki[2 * q + 1]};
}
__device__ __forceinline__ void passC_mul(f32x2* X, const f32x2* __restrict__ K, int g) {
    float re[16], im[16];
    f32x4 kv[8];
#pragma unroll
    for (int q = 0; q < 8; ++q) kv[q] = *(const f32x4*)(K + 16 * g + 2 * q);
#pragma unroll
    for (int a3 = 0; a3 < 16; ++a3) { const f32x2 v = X[phC(g, a3)]; re[a3] = v.x; im[a3] = v.y; }
    fft_reg<16, false>(re, im);
    float nr[16], ni[16];
#pragma unroll
    for (int i = 0; i < 16; ++i) { const int ka = brev(i, 4); const float kr = (ka & 1) ? kv[ka >> 1].z : kv[ka >> 1].x, ki = (ka & 1) ? kv[ka >> 1].w : kv[ka >> 1].y;
        nr[ka] = re[i] * kr - im[i] * ki; ni[ka] = re[i] * ki + im[i] * kr; }
    fft_reg<16, true>(nr, ni);
#pragma unroll
    for (int i = 0; i < 16; ++i) X[phC(g, brev(i, 4))] = (f32x2){nr[i], ni[i]};
}
__device__ __forceinline__ void mid_passes(f32x2* X, const f32x2* TW, const f32x2* __restrict__ K, int tid) {
    __syncthreads();
    passB_fwd(X, TW, opq(tid));
    __syncthreads();
#pragma unroll 1
    for (int h2 = 0; h2 < 2; ++h2) passC_mul(X, K, opq(tid) + 512 * h2);
    __syncthreads();
    passB_inv(X, TW, opq(tid));
    __syncthreads();
}
}
#define F_tw ((f32x2*)(F.ws + WS_TW))
#define F_kf ((f32x2*)(F.ws + WS_KF))
__device__ __forceinline__ void hyena_fft_filters(Frame& F, int layer, int c) {
    f32x2* X = (f32x2*)F.ldsg;
    const f32x2* TW = F_tw; f32x2* KF = F_kf + (size_t)F.bid * 2 * hyf::N;
    const float* cw = FIN(IN_HCW) + layer * 3 * HYP; const float* cb = FIN(IN_HCB) + layer * HYP;
    const float mind = -4.605170185988091f / 1.5f, maxd = -4.605170185988091f / 0.3f;
    const float adelta = fabsf(mind + (float)c * ((maxd - mind) / 511.0f));
    const int tid = hyf::opq(F.tid);
    { typedef short bf16x8v __attribute__((ext_vector_type(8)));
      const int lane = tid & 63, wv = tid >> 6, fr = lane & 15, fq = lane >> 4;
      bf16x8v wf0 = {0, 0, 0, 0, 0, 0, 0, 0}, wf1 = {0, 0, 0, 0, 0, 0, 0, 0};
      if (fr < 4) { const int j = (fr >> 1) * 1024 + (fr & 1) * 512 + c; const float* wp = FIN(IN_FW3) + (size_t)layer * 64 * 2048 + j;
#pragma unroll
          for (int e = 0; e < 8; ++e) { wf0[e] = (short)f2bf(wp[(size_t)(8 * fq + e) * 2048]); wf1[e] = (short)f2bf(wp[(size_t)(32 + 8 * fq + e) * 2048]); } }
      const bf16* a2b = (const bf16*)(F.ws + WS_A2B) + (size_t)layer * SEQ * 64;
      float* Sf = (float*)(F.ws + WS_HS) + (size_t)launder_u((unsigned)F.bid) * 6 * SEQ;
      const float b3a = FIN(IN_FB3)[layer * 2048 + c], b3b = FIN(IN_FB3)[layer * 2048 + 512 + c], b3c = FIN(IN_FB3)[layer * 2048 + 1024 + c], b3d = FIN(IN_FB3)[layer * 2048 + 1536 + c];
      __syncthreads();
      if (tid == 256) X[hyf::phA(0, 16)] = (f32x2){0.f, 0.f};
#pragma unroll 2
      for (int blk = wv; blk < SEQ / 16; blk += NWAVES) { const int m = 16 * blk + fr;
          const bf16x8v a0 = *(const bf16x8v*)(a2b + (size_t)m * 64 + 8 * fq), a1 = *(const bf16x8v*)(a2b + (size_t)m * 64 + 32 + 8 * fq);
          f32x4 acc = (f32x4){0.f, 0.f, 0.f, 0.f};
          acc = __builtin_amdgcn_mfma_f32_16x16x32_bf16(wf0, a0, acc, 0, 0, 0); acc = __builtin_amdgcn_mfma_f32_16x16x32_bf16(wf1, a1, acc, 0, 0, 0);
          if (fq == 0) { const float dec = __expf(-((float)m / (float)(SEQ - 1)) * adelta);
              X[hyf::phA(m & 511, m >> 9)] = (f32x2){(acc.x + b3a) * dec, 0.f};
              if (m >= 1) { const int p = hyf::N - m; X[hyf::phA(p & 511, p >> 9)] = (f32x2){(acc.y + b3b) * dec, 0.f}; }
              Sf[m] = (acc.z + b3c) * dec; Sf[SEQ + m] = (acc.w + b3d) * dec; } }
#pragma unroll 1
      for (int o = 0; o < 2; ++o) {
          if (o == 1) {
              __syncthreads();
              if (tid == 256) X[hyf::phA(0, 16)] = (f32x2){0.f, 0.f};
              for (int blk = wv; blk < SEQ / 16; blk += NWAVES) if (fq == 0) { const int m = 16 * blk + fr; X[hyf::phA(m & 511, m >> 9)] = (f32x2){Sf[m], 0.f};
                  if (m >= 1) { const int p = hyf::N - m; X[hyf::phA(p & 511, p >> 9)] = (f32x2){Sf[SEQ + m], 0.f}; } }
          }
          __syncthreads();
          { float re[32], im[32];
#pragma unroll
            for (int b = 0; b < 32; ++b) { const f32x2 v = X[hyf::phA(tid, b)]; re[b] = v.x; im[b] = v.y; }
            hyf::passA_fwd(X, TW, re, im, hyf::opq(tid)); }
          __syncthreads();
          hyf::passB_fwd(X, TW, hyf::opq(tid));
          __syncthreads();
          hyf::passC_filter(X, KF + (size_t)o * hyf::N, hyf::opq(tid)); hyf::passC_filter(X, KF + (size_t)o * hyf::N, hyf::opq(tid) + 512);
      } }
    asm volatile("s_waitcnt vmcnt(0)" ::: "memory");
    __syncthreads();
}
__device__ __forceinline__ float bld_f32(__amdgpu_buffer_rsrc_t r, unsigned voff, unsigned soff) { return __builtin_bit_cast(float, __builtin_amdgcn_raw_buffer_load_b32(r, voff, soff, 0)); }
__device__ __forceinline__ void bst_b16f(__amdgpu_buffer_rsrc_t r, unsigned voff, unsigned soff, float v) { __builtin_amdgcn_raw_buffer_store_b16((short)f2bf(v), r, voff, soff, 0); }
__device__ __forceinline__ void bst_f32(__amdgpu_buffer_rsrc_t r, unsigned voff, unsigned soff, float v) { __builtin_amdgcn_raw_buffer_store_b32(__builtin_bit_cast(unsigned, v), r, voff, soff, 0); }
__device__ __forceinline__ float bld_bf16(__amdgpu_buffer_rsrc_t r, unsigned voff, unsigned soff) { return __uint_as_float(((unsigned)__builtin_amdgcn_raw_buffer_load_b16(r, voff, soff, 0)) << 16); }
__device__ __forceinline__ float hy_short_b(__amdgpu_buffer_rsrc_t r, unsigned rowb, unsigned v2, int tid, int b, float w0, float w1, float w2, float bb) {
    const unsigned so = rowb + 1024u * (unsigned)b - 2u;
    float um = bld_bf16(r, v2, so), u0 = bld_bf16(r, v2, so + 2u), up = bld_bf16(r, v2, so + 4u);
    if (b == 0 && tid == 0) um = 0.f; if (b == 15 && tid == 511) up = 0.f;
    return w0 * um + w1 * u0 + w2 * up + bb;
}
__device__ __forceinline__ void hyena_fft_data(Frame& F, int layer, int c) {
    f32x2* X = (f32x2*)F.ldsg;
    const f32x2* TW = F_tw; const f32x2* KF = F_kf + (size_t)F.bid * 2 * hyf::N;
    const float* cw = FIN(IN_HCW) + layer * 3 * HYP; const float* cb = FIN(IN_HCB) + layer * HYP;
    const int tid = hyf::opq(F.tid); const unsigned v4 = 4u * (unsigned)tid, v2 = 2u * (unsigned)tid;
    const __amdgpu_buffer_rsrc_t R = __builtin_amdgcn_make_buffer_rsrc((void*)F.ws, 0, (unsigned)WS_END, 0x00020000);
    const unsigned Sb = (unsigned)(WS_HS + (size_t)F.bid * 6 * SEQ * 4);
    const float hb0 = FIN(IN_HBIAS)[layer * 1024 + c], hb1 = FIN(IN_HBIAS)[layer * 1024 + 512 + c];
#pragma unroll 1
    for (int pr = 0; pr < 2; ++pr) {
        const unsigned oab = (unsigned)(WS_ZT + ((size_t)c * MTOT + (size_t)(2 * pr) * SEQ) * 4), obb = oab + SEQ * 4;
#pragma unroll 1
        for (int r = 0; r < 3; ++r) { const int ch = r * HYW + c; const unsigned ua = (unsigned)(WS_HYT + ((size_t)ch * MTOT + (size_t)(2 * pr) * SEQ) * 2), ub = ua + SEQ * 2;
            const float w0 = cw[ch], w1 = cw[HYP + ch], w2 = cw[2 * HYP + ch], bb = cb[ch];
#pragma unroll
            for (int b = 0; b < 16; ++b) { bst_f32(R, v4, Sb + (unsigned)((2 * r) * SEQ * 4 + 2048 * b), hy_short_b(R, ua, v2, tid, b, w0, w1, w2, bb));
                                           bst_f32(R, v4, Sb + (unsigned)((2 * r + 1) * SEQ * 4 + 2048 * b), hy_short_b(R, ub, v2, tid, b, w0, w1, w2, bb)); } }
#pragma unroll 1
        for (int o = 0; o < 2; ++o) {
            const unsigned ina = o == 0 ? Sb : oab, inb = o == 0 ? Sb + SEQ * 4 : obb, ga = Sb + (unsigned)((2 + 2 * o) * SEQ * 4), gb = ga + SEQ * 4;
            const float hb = o == 0 ? hb0 : hb1;
            { float re[32], im[32];
#pragma unroll
              for (int b = 0; b < 16; ++b) { re[b] = bld_f32(R, v4, ina + 2048u * b); im[b] = bld_f32(R, v4, inb + 2048u * b); re[16 + b] = 0.f; im[16 + b] = 0.f; }
              hyf::passA_fwd(X, TW, re, im, hyf::opq(tid)); }
            hyf::mid_passes(X, TW, KF + (size_t)o * hyf::N, tid);
            { float re[32], im[32]; hyf::passA_inv(X, TW, re, im, hyf::opq(tid));
#pragma unroll
              for (int i = 0; i < 32; ++i) { const int b = hyf::brev(i, 5); if (b < 16) { const unsigned q = 2048u * b;
                  const float za = bld_f32(R, v4, ina + q), zb = bld_f32(R, v4, inb + q);
                  bst_f32(R, v4, oab + q, bld_f32(R, v4, ga + q) * (re[i] + za * hb)); bst_f32(R, v4, obb + q, bld_f32(R, v4, gb + q) * (im[i] + zb * hb)); } } }
        }
    }
    __syncthreads();
}
namespace hym {
typedef short bf16x8v __attribute__((ext_vector_type(8)));
typedef float f32x16v __attribute__((ext_vector_type(16)));
constexpr int N = 16384;
constexpr int T_F32F = 0, T_F32I = 8, T_F32IH = 16, T_F16F = 20, T_F16IP = 22, T_NFRAG = 24;
__device__ __forceinline__ int crow(int r, int hi) { return (r & 3) + 8 * (r >> 2) + 4 * hi; }
__device__ __forceinline__ float dft_entry(int f, int lane, int j) {
    const int n = lane & 31, hi = lane >> 5;
    int R, sign, m, k;
    if (f < T_F32IH) { R = 32; sign = f < T_F32I ? -1 : 1; const int q = f & 7, mt = q >> 2, s_ = q & 3; m = 32 * mt + n; k = 16 * s_ + 8 * hi + j; }
    else if (f < T_F16F) { R = 32; sign = 1; const int s_ = f - T_F32IH; m = n < 16 ? n : 32 + (n - 16); k = 16 * s_ + 8 * hi + j; }
    else if (f < T_F16IP) { R = 16; sign = -1; const int s_ = f - T_F16F; m = n; k = 16 * s_ + 8 * hi + j; }
    else { R = 16; sign = 1; const int s_ = f - T_F16IP; m = n; k = crow(8 * s_ + j, hi); }
    const int mp = m / R, mi = m % R, kp = k / R, ki = k % R;
    const double ang = 6.283185307179586476925 * (double)((mi * ki) % R) / (double)R; const double fr = cos(ang), fi = (double)sign * sin(ang);
    return (float)(mp == 0 ? (kp == 0 ? fr : -fi) : (kp == 0 ? fi : fr));
}
__device__ __forceinline__ unsigned cvtpk(float lo, float hi) { unsigned r; asm volatile("v_cvt_pk_bf16_f32 %0, %1, %2" : "=v"(r) : "v"(lo), "v"(hi)); return r; }
__device__ __forceinline__ bf16x8v pack8(const float (&v)[8]) { v4u w; w.x = cvtpk(v[0], v[1]); w.y = cvtpk(v[2], v[3]); w.z = cvtpk(v[4], v[5]); w.w = cvtpk(v[6], v[7]); return __builtin_bit_cast(bf16x8v, w); }
__device__ __forceinline__ bf16x8v afrag(const bf16* tab, int f, int lane) { return *(const bf16x8v*)(tab + ((size_t)f * 64 + lane) * 8); }
__device__ __forceinline__ void ld_F32F(bf16x8v (&fr)[8], const bf16* tab, int lane) {
#pragma unroll
    for (int i = 0; i < 8; ++i) fr[i] = afrag(tab, T_F32F + i, lane); }
__device__ __forceinline__ void ld_F32I(bf16x8v (&fr)[8], const bf16* tab, int lane) {
#pragma unroll
    for (int i = 0; i < 8; ++i) fr[i] = afrag(tab, T_F32I + i, lane); }
__device__ __forceinline__ void ld_A(bf16x8v (&fr)[4], const bf16* tab, int lane, bool from_lds) { fr[0] = afrag(tab, T_F32F + 0, lane); fr[1] = afrag(tab, T_F32F + 4, lane); fr[2] = afrag(tab, T_F32F + (from_lds ? 1 : 2), lane); fr[3] = afrag(tab, T_F32F + 4 + (from_lds ? 1 : 2), lane); }
__device__ __forceinline__ void ld_C(bf16x8v (&fr)[4], const bf16* tab, int lane) { fr[0] = afrag(tab, T_F16F + 0, lane); fr[1] = afrag(tab, T_F16F + 1, lane); fr[2] = afrag(tab, T_F16IP + 0, lane); fr[3] = afrag(tab, T_F16IP + 1, lane); }
__device__ __forceinline__ void ld_AH(bf16x8v (&fr)[4], const bf16* tab, int lane) {
#pragma unroll
    for (int i = 0; i < 4; ++i) fr[i] = afrag(tab, T_F32IH + i, lane); }
using hyf::phA; using hyf::phB; using hyf::phC;
__device__ __forceinline__ void tw5(int e, float sg, f32x2 (&b)[5]) {
#pragma unroll
    for (int j = 0; j < 5; ++j) { const float x = (float)((e << j) & (N - 1)) * (1.0f / N); b[j].x = __builtin_amdgcn_cosf(x); b[j].y = sg * __builtin_amdgcn_sinf(x); }
}
__device__ __forceinline__ f32x2 cmul(f32x2 a, f32x2 b) {
    f32x2 t, r;
    asm("s_nop 0\n\tv_pk_mul_f32 %0, %1, %2 op_sel_hi:[0,1]" : "=v"(t) : "v"(a), "v"(b));
    asm("v_pk_fma_f32 %0, %1, %2, %3 op_sel:[1,1,0] op_sel_hi:[1,0,1] neg_lo:[1,0,0]" : "=v"(r) : "v"(a), "v"(b), "v"(t));
    return r;
}
template <int H>
__device__ __forceinline__ f32x2 cmul_acc(f32x2 re, f32x2 im, f32x2 w) {
    f32x2 t, r;
    if (H == 0) { asm("v_pk_mul_f32 %0, %1, %2 op_sel_hi:[0,1]" : "=v"(t) : "v"(re), "v"(w));
                  asm("v_pk_fma_f32 %0, %1, %2, %3 op_sel:[0,1,0] op_sel_hi:[0,0,1] neg_lo:[1,0,0]" : "=v"(r) : "v"(im), "v"(w), "v"(t)); }
    else        { asm("v_pk_mul_f32 %0, %1, %2 op_sel:[1,0] op_sel_hi:[1,1]" : "=v"(t) : "v"(re), "v"(w));
                  asm("v_pk_fma_f32 %0, %1, %2, %3 op_sel:[1,1,0] op_sel_hi:[1,0,1] neg_lo:[1,0,0]" : "=v"(r) : "v"(im), "v"(w), "v"(t)); }
    return r;
}
#define ACC_PAIR(C_, R_) ((f32x2){(C_)[(R_) & ~1], (C_)[(R_) | 1]})
__device__ __forceinline__ void tw_rows(int e, float sg, int hi, f32x2 (&lo4)[4], f32x2 (&hi4)[4]) {
    f32x2 b[5]; tw5(e, sg, b);
    const f32x2 t = hi ? b[2] : (f32x2){1.f, 0.f};
    lo4[0] = t; lo4[1] = cmul(t, b[0]); lo4[2] = cmul(t, b[1]); lo4[3] = cmul(lo4[1], b[1]);
    hi4[0] = (f32x2){1.f, 0.f}; hi4[1] = b[3]; hi4[2] = b[4]; hi4[3] = cmul(b[3], b[4]);
}
__device__ __forceinline__ void tw_cols(int e, float sg, int hi, f32x2 (&lo8)[8], f32x2 (&hx)[2]) {
    f32x2 b[5]; tw5(e, sg, b);
    lo8[0] = (f32x2){1.f, 0.f}; lo8[1] = b[0]; lo8[2] = b[1]; lo8[3] = cmul(b[0], b[1]); lo8[4] = b[2]; lo8[5] = cmul(b[2], b[0]); lo8[6] = cmul(b[2], b[1]); lo8[7] = cmul(b[2], lo8[3]);
    hx[0] = hi ? b[3] : (f32x2){1.f, 0.f}; hx[1] = cmul(hx[0], b[4]);
}
#define HYM_MFMA(a, b, c) __builtin_amdgcn_mfma_f32_32x32x16_bf16(a, b, c, 0, 0, 0)
template <bool FROM_LDS>
__device__ __forceinline__ void passA_fwd(f32x2* X, const bf16x8v (&fr)[4], __amdgpu_buffer_rsrc_t R, unsigned ina, unsigned inb, int tid) {
    const int lane = tid & 63, w = tid >> 6, n = lane & 31, hi = lane >> 5;
    const bf16x8v A0a = fr[0], A1a = fr[1], A0b = fr[2], A1b = fr[3];
#pragma unroll
    for (int nt = 0; nt < 2; ++nt) { const int a = 64 * w + 32 * nt + n;
        float u0[8], u1[8];
        if (FROM_LDS) {
#pragma unroll
            for (int j = 0; j < 8; ++j) { u0[j] = X[phA(a, 8 * hi + j)].x; u1[j] = X[phA(a, 16 + 8 * hi + j)].x; }
        } else { const unsigned vo = 4u * (unsigned)a + 16384u * (unsigned)hi;
#pragma unroll
            for (int j = 0; j < 8; ++j) { u0[j] = bld_f32(R, vo, ina + 2048u * j); u1[j] = bld_f32(R, vo, inb + 2048u * j); } }
        const bf16x8v B0 = pack8(u0), B1 = pack8(u1);
        f32x16v c0 = {}, c1 = {};
        c0 = HYM_MFMA(A0a, B0, c0); c1 = HYM_MFMA(A1a, B0, c1); c0 = HYM_MFMA(A0b, B1, c0); c1 = HYM_MFMA(A1b, B1, c1);
        f32x2 lo4[4], hi4[4]; tw_rows(a, -1.f, hi, lo4, hi4);
        asm volatile("s_nop 7\n\ts_nop 3" : "+v"(c0), "+v"(c1));
#pragma unroll
        for (int r = 0; r < 16; ++r) { const f32x2 wv = (r >> 2) == 0 ? lo4[r & 3] : cmul(lo4[r & 3], hi4[r >> 2]); X[phA(a, crow(r, hi))] = (r & 1) ? cmul_acc<1>(ACC_PAIR(c0, r), ACC_PAIR(c1, r), wv) : cmul_acc<0>(ACC_PAIR(c0, r), ACC_PAIR(c1, r), wv); } }
}
__device__ __forceinline__ void passB_fwd(f32x2* X, const bf16x8v (&fr)[8], int tid) {
    const int lane = tid & 63, w = tid >> 6, n = lane & 31, hi = lane >> 5;
    bf16x8v A0[4], A1[4];
#pragma unroll
    for (int s_ = 0; s_ < 4; ++s_) { A0[s_] = fr[s_]; A1[s_] = fr[4 + s_]; }
#pragma unroll
    for (int nt = 0; nt < 2; ++nt) { const int v = 64 * w + 32 * nt + n, kb = v >> 4, a2 = v & 15;
        float xr0[8], xi0[8], xr1[8], xi1[8];
#pragma unroll
        for (int j = 0; j < 8; ++j) { const f32x2 p = X[phB(kb, a2, 8 * hi + j)], q = X[phB(kb, a2, 16 + 8 * hi + j)]; xr0[j] = p.x; xi0[j] = p.y; xr1[j] = q.x; xi1[j] = q.y; }
        const bf16x8v B0 = pack8(xr0), B1 = pack8(xr1), B2 = pack8(xi0), B3 = pack8(xi1);
        f32x16v c0 = {}, c1 = {};
        c0 = HYM_MFMA(A0[0], B0, c0); c1 = HYM_MFMA(A1[0], B0, c1); c0 = HYM_MFMA(A0[1], B1, c0); c1 = HYM_MFMA(A1[1], B1, c1);
        c0 = HYM_MFMA(A0[2], B2, c0); c1 = HYM_MFMA(A1[2], B2, c1); c0 = HYM_MFMA(A0[3], B3, c0); c1 = HYM_MFMA(A1[3], B3, c1);
        f32x2 lo4[4], hi4[4]; tw_rows(32 * a2, -1.f, hi, lo4, hi4);
        asm volatile("s_nop 7\n\ts_nop 3" : "+v"(c0), "+v"(c1));
#pragma unroll
        for (int r = 0; r < 16; ++r) { const f32x2 wv = (r >> 2) == 0 ? lo4[r & 3] : cmul(lo4[r & 3], hi4[r >> 2]); X[phB(kb, a2, crow(r, hi))] = (r & 1) ? cmul_acc<1>(ACC_PAIR(c0, r), ACC_PAIR(c1, r), wv) : cmul_acc<0>(ACC_PAIR(c0, r), ACC_PAIR(c1, r), wv); } }
}
__device__ __forceinline__ void passB_inv(f32x2* X, const bf16x8v (&fr)[8], int tid) {
    const int lane = tid & 63, w = tid >> 6, n = lane & 31, hi = lane >> 5;
    bf16x8v A0[4], A1[4];
#pragma unroll
    for (int s_ = 0; s_ < 4; ++s_) { A0[s_] = fr[s_]; A1[s_] = fr[4 + s_]; }
#pragma unroll
    for (int nt = 0; nt < 2; ++nt) { const int v = 64 * w + 32 * nt + n, kb = v >> 4, a2 = v & 15;
        f32x2 lo8[8], hx[2]; tw_cols(32 * a2, 1.f, hi, lo8, hx);
        float xr0[8], xi0[8], xr1[8], xi1[8];
#pragma unroll
        for (int j = 0; j < 8; ++j) { const f32x2 p = cmul(X[phB(kb, a2, 8 * hi + j)], (j == 0 ? hx[0] : cmul(lo8[j], hx[0]))), q = cmul(X[phB(kb, a2, 16 + 8 * hi + j)], (j == 0 ? hx[1] : cmul(lo8[j], hx[1])));
            xr0[j] = p.x; xi0[j] = p.y; xr1[j] = q.x; xi1[j] = q.y; }
        const bf16x8v B0 = pack8(xr0), B1 = pack8(xr1), B2 = pack8(xi0), B3 = pack8(xi1);
        f32x16v c0 = {}, c1 = {};
        c0 = HYM_MFMA(A0[0], B0, c0); c1 = HYM_MFMA(A1[0], B0, c1); c0 = HYM_MFMA(A0[1], B1, c0); c1 = HYM_MFMA(A1[1], B1, c1);
        c0 = HYM_MFMA(A0[2], B2, c0); c1 = HYM_MFMA(A1[2], B2, c1); c0 = HYM_MFMA(A0[3], B3, c0); c1 = HYM_MFMA(A1[3], B3, c1);
#pragma unroll
        for (int r = 0; r < 16; ++r) X[phB(kb, a2, crow(r, hi))] = (f32x2){c0[r], c1[r]}; }
}
template <bool MUL>
__device__ __forceinline__ void passC(f32x2* X, const bf16x8v (&fr)[4], f32x2* __restrict__ K, int tid) {
    const int lane = tid & 63, w = tid >> 6, n = lane & 31, hi = lane >> 5;
    const bf16x8v F0 = fr[0], F1 = fr[1], I0 = fr[2], I1 = fr[3];
#pragma unroll 2
    for (int nt = 0; nt < 4; ++nt) { const int g = 128 * w + 32 * nt + n;
        f32x4 kv[4];
        if (MUL) { const f32x4* kp = (const f32x4*)(K + 16 * g + 4 * hi); kv[0] = kp[0]; kv[1] = kp[1]; kv[2] = kp[4]; kv[3] = kp[5]; }
        float xr[8], xi[8];
#pragma unroll
        for (int j = 0; j < 8; ++j) { const f32x2 p = X[phC(g, 8 * hi + j)]; xr[j] = p.x; xi[j] = p.y; }
        f32x16v c = {};
        c = HYM_MFMA(F0, pack8(xr), c); c = HYM_MFMA(F1, pack8(xi), c);
        if (MUL) {
            float pr[8], pi[8];
            asm volatile("s_nop 7\n\ts_nop 3" : "+v"(c));
#pragma unroll
            for (int r = 0; r < 8; ++r) { const f32x4 kq = kv[(r >> 2) * 2 + ((r & 3) >> 1)]; const f32x2 kk = (r & 1) ? (f32x2){kq.z, kq.w} : (f32x2){kq.x, kq.y};
                const f32x2 re = (f32x2){c[r & ~1], c[r | 1]}, im = (f32x2){c[8 + (r & ~1)], c[8 + (r | 1)]};
                const f32x2 y = (r & 1) ? cmul_acc<1>(re, im, kk) : cmul_acc<0>(re, im, kk); pr[r] = y.x; pi[r] = y.y; }
            f32x16v d = {};
            d = HYM_MFMA(I0, pack8(pr), d); d = HYM_MFMA(I1, pack8(pi), d);
#pragma unroll
            for (int r = 0; r < 8; ++r) X[phC(g, crow(r, hi))] = (f32x2){d[r], d[8 + r]};
        } else {
            f32x4* kp = (f32x4*)(K + 16 * g + 4 * hi); const float sc = 1.0f / N;
            kp[0] = (f32x4){c[0] * sc, c[8] * sc, c[1] * sc, c[9] * sc}; kp[1] = (f32x4){c[2] * sc, c[10] * sc, c[3] * sc, c[11] * sc};
            kp[4] = (f32x4){c[4] * sc, c[12] * sc, c[5] * sc, c[13] * sc}; kp[5] = (f32x4){c[6] * sc, c[14] * sc, c[7] * sc, c[15] * sc};
        } }
}
__device__ __forceinline__ void passA_fwd_cplx(f32x2* X, const bf16x8v (&fr)[8], int tid) {
    const int lane = tid & 63, w = tid >> 6, n = lane & 31, hi = lane >> 5;
    bf16x8v A0[4], A1[4];
#pragma unroll
    for (int s_ = 0; s_ < 4; ++s_) { A0[s_] = fr[s_]; A1[s_] = fr[4 + s_]; }
#pragma unroll
    for (int nt = 0; nt < 2; ++nt) { const int a = 64 * w + 32 * nt + n;
        float xr0[8], xi0[8], xr1[8], xi1[8];
#pragma unroll
        for (int j = 0; j < 8; ++j) { const f32x2 p = X[phA(a, 8 * hi + j)], q = X[phA(a, 16 + 8 * hi + j)]; xr0[j] = p.x; xi0[j] = p.y; xr1[j] = q.x; xi1[j] = q.y; }
        const bf16x8v B0 = pack8(xr0), B1 = pack8(xr1), B2 = pack8(xi0), B3 = pack8(xi1);
        f32x16v c0 = {}, c1 = {};
        c0 = HYM_MFMA(A0[0], B0, c0); c1 = HYM_MFMA(A1[0], B0, c1); c0 = HYM_MFMA(A0[1], B1, c0); c1 = HYM_MFMA(A1[1], B1, c1);
        c0 = HYM_MFMA(A0[2], B2, c0); c1 = HYM_MFMA(A1[2], B2, c1); c0 = HYM_MFMA(A0[3], B3, c0); c1 = HYM_MFMA(A1[3], B3, c1);
        f32x2 lo4[4], hi4[4]; tw_rows(a, -1.f, hi, lo4, hi4);
        asm volatile("s_nop 7\n\ts_nop 3" : "+v"(c0), "+v"(c1));
#pragma unroll
        for (int r = 0; r < 16; ++r) { const f32x2 wv = (r >> 2) == 0 ? lo4[r & 3] : cmul(lo4[r & 3], hi4[r >> 2]); X[phA(a, crow(r, hi))] = (r & 1) ? cmul_acc<1>(ACC_PAIR(c0, r), ACC_PAIR(c1, r), wv) : cmul_acc<0>(ACC_PAIR(c0, r), ACC_PAIR(c1, r), wv); } }
}
__device__ __forceinline__ void passC_store(f32x2* X, const bf16x8v (&fr)[4], int tid) {
    const int lane = tid & 63, w = tid >> 6, n = lane & 31, hi = lane >> 5;
    const bf16x8v F0 = fr[0], F1 = fr[1];
#pragma unroll 2
    for (int nt = 0; nt < 4; ++nt) { const int g = 128 * w + 32 * nt + n;
        float xr[8], xi[8];
#pragma unroll
        for (int j = 0; j < 8; ++j) { const f32x2 p = X[phC(g, 8 * hi + j)]; xr[j] = p.x; xi[j] = p.y; }
        f32x16v c = {};
        c = HYM_MFMA(F0, pack8(xr), c); c = HYM_MFMA(F1, pack8(xi), c);
#pragma unroll
        for (int r = 0; r < 8; ++r) X[phC(g, crow(r, hi))] = (f32x2){c[r] * (1.0f / N), c[8 + r] * (1.0f / N)}; }
}
__device__ __forceinline__ void split_spectra(const f32x2* X, f32x2* __restrict__ K1, f32x2* __restrict__ K2, int tid) {
#pragma unroll 4
    for (int i = 0; i < 32; ++i) { const int p = tid + 512 * i, kb = p >> 9, kb2 = (p >> 4) & 31, ka = p & 15;
        const int b1 = kb != 0, kbp = (32 - kb) & 31, kb2p = (32 - kb2 - b1) & 31, b2 = (kb2 != 0) | b1, kap = (16 - ka - b2) & 15;
        const f32x2 fk = X[phC(p >> 4, ka)], fp = X[phC(32 * kbp + kb2p, kap)];
        K1[p] = (f32x2){0.5f * (fk.x + fp.x), 0.5f * (fk.y - fp.y)};
        K2[p] = (f32x2){0.5f * (fk.y + fp.y), -0.5f * (fk.x - fp.x)}; }
}
__device__ __forceinline__ void passA_inv_gate(const f32x2* X, const bf16x8v (&fr)[4], __amdgpu_buffer_rsrc_t R, unsigned ina, unsigned inb, unsigned ga, unsigned gb, unsigned oa, unsigned ob, float hb, int tid) {
    const int lane = tid & 63, w = tid >> 6, n = lane & 31, hi = lane >> 5;
    bf16x8v AH[4];
#pragma unroll
    for (int s_ = 0; s_ < 4; ++s_) AH[s_] = fr[s_];
#pragma unroll
    for (int nt = 0; nt < 2; ++nt) { const int a = 64 * w + 32 * nt + n;
        f32x2 lo8[8], hx[2]; tw_cols(a, 1.f, hi, lo8, hx);
        float xr0[8], xi0[8], xr1[8], xi1[8];
#pragma unroll
        for (int j = 0; j < 8; ++j) { const f32x2 p = cmul(X[phA(a, 8 * hi + j)], (j == 0 ? hx[0] : cmul(lo8[j], hx[0]))), q = cmul(X[phA(a, 16 + 8 * hi + j)], (j == 0 ? hx[1] : cmul(lo8[j], hx[1])));
            xr0[j] = p.x; xi0[j] = p.y; xr1[j] = q.x; xi1[j] = q.y; }
        f32x16v c = {};
        c = HYM_MFMA(AH[0], pack8(xr0), c); c = HYM_MFMA(AH[1], pack8(xr1), c); c = HYM_MFMA(AH[2], pack8(xi0), c); c = HYM_MFMA(AH[3], pack8(xi1), c);
        const unsigned vo = 4u * (unsigned)a + 8192u * (unsigned)hi;
        float za[8], zb[8], gva[8], gvb[8];
#pragma unroll
        for (int r = 0; r < 8; ++r) { const unsigned so = 2048u * (unsigned)((r & 3) + 8 * (r >> 2));
            za[r] = bld_f32(R, vo, ina + so); zb[r] = bld_f32(R, vo, inb + so); gva[r] = bld_f32(R, vo, ga + so); gvb[r] = bld_f32(R, vo, gb + so); }
#pragma unroll
        for (int r = 0; r < 8; ++r) { const unsigned so = 2048u * (unsigned)((r & 3) + 8 * (r >> 2));
            bst_f32(R, vo, oa + so, gva[r] * (c[r] + za[r] * hb)); bst_f32(R, vo, ob + so, gvb[r] * (c[8 + r] + zb[r] * hb)); } }
}
__device__ __forceinline__ void passA_inv_gate_r(const f32x2* X, const bf16x8v (&fr)[4], __amdgpu_buffer_rsrc_t R, unsigned ina, unsigned inb, unsigned ga, unsigned gb, float hb, int tid, float (&zo)[2][16]) {
    const int lane = tid & 63, w = tid >> 6, n = lane & 31, hi = lane >> 5;
    bf16x8v AH[4];
#pragma unroll
    for (int s_ = 0; s_ < 4; ++s_) AH[s_] = fr[s_];
#pragma unroll
    for (int nt = 0; nt < 2; ++nt) { const int a = 64 * w + 32 * nt + n;
        const unsigned vo = 4u * (unsigned)a + 8192u * (unsigned)hi;
        float za[8], zb[8], gva[8], gvb[8];
#pragma unroll
        for (int r = 0; r < 8; ++r) { const unsigned so = 2048u * (unsigned)((r & 3) + 8 * (r >> 2));
            za[r] = bld_f32(R, vo, ina + so); zb[r] = bld_f32(R, vo, inb + so); gva[r] = bld_f32(R, vo, ga + so); gvb[r] = bld_f32(R, vo, gb + so); }
        f32x2 lo8[8], hx[2]; tw_cols(a, 1.f, hi, lo8, hx);
        float xr0[8], xi0[8], xr1[8], xi1[8];
#pragma unroll
        for (int j = 0; j < 8; ++j) { const f32x2 p = cmul(X[phA(a, 8 * hi + j)], (j == 0 ? hx[0] : cmul(lo8[j], hx[0]))), q = cmul(X[phA(a, 16 + 8 * hi + j)], (j == 0 ? hx[1] : cmul(lo8[j], hx[1])));
            xr0[j] = p.x; xi0[j] = p.y; xr1[j] = q.x; xi1[j] = q.y; }
        f32x16v c = {};
        c = HYM_MFMA(AH[0], pack8(xr0), c); c = HYM_MFMA(AH[1], pack8(xr1), c); c = HYM_MFMA(AH[2], pack8(xi0), c); c = HYM_MFMA(AH[3], pack8(xi1), c);
#pragma unroll
        for (int r = 0; r < 8; ++r) { zo[nt][r] = gva[r] * (c[r] + za[r] * hb); zo[nt][8 + r] = gvb[r] * (c[8 + r] + zb[r] * hb); } }
}
__device__ __forceinline__ void passA_fwd_r(f32x2* X, const bf16x8v (&fr)[4], const float (&zi)[2][16], int tid) {
    const int lane = tid & 63, w = tid >> 6, n = lane & 31, hi = lane >> 5;
    const bf16x8v A0a = fr[0], A1a = fr[1], A0b = fr[2], A1b = fr[3];
#pragma unroll
    for (int nt = 0; nt < 2; ++nt) { const int a = 64 * w + 32 * nt + n;
        float u0[8], u1[8];
#pragma unroll
        for (int k = 0; k < 4; ++k) {
            { auto rr = __builtin_amdgcn_permlane32_swap(__float_as_uint(zi[nt][k]), __float_as_uint(zi[nt][4 + k]), false, false); u0[k] = __uint_as_float(rr[0]); u0[4 + k] = __uint_as_float(rr[1]); }
            { auto rr = __builtin_amdgcn_permlane32_swap(__float_as_uint(zi[nt][8 + k]), __float_as_uint(zi[nt][12 + k]), false, false); u1[k] = __uint_as_float(rr[0]); u1[4 + k] = __uint_as_float(rr[1]); } }
        const bf16x8v B0 = pack8(u0), B1 = pack8(u1);
        f32x16v c0 = {}, c1 = {};
        c0 = HYM_MFMA(A0a, B0, c0); c1 = HYM_MFMA(A1a, B0, c1); c0 = HYM_MFMA(A0b, B1, c0); c1 = HYM_MFMA(A1b, B1, c1);
        f32x2 lo4[4], hi4[4]; tw_rows(a, -1.f, hi, lo4, hi4);
        asm volatile("s_nop 7\n\ts_nop 3" : "+v"(c0), "+v"(c1));
#pragma unroll
        for (int r = 0; r < 16; ++r) { const f32x2 wv = (r >> 2) == 0 ? lo4[r & 3] : cmul(lo4[r & 3], hi4[r >> 2]); X[phA(a, crow(r, hi))] = (r & 1) ? cmul_acc<1>(ACC_PAIR(c0, r), ACC_PAIR(c1, r), wv) : cmul_acc<0>(ACC_PAIR(c0, r), ACC_PAIR(c1, r), wv); } }
}
__device__ __forceinline__ void passA_inv_gate_f(const f32x2* X, const bf16x8v (&fr)[4], __amdgpu_buffer_rsrc_t R, unsigned ga, unsigned gb, unsigned oa, unsigned ob, float hb, int tid, const float (&zi)[2][16]) {
    const int lane = tid & 63, w = tid >> 6, n = lane & 31, hi = lane >> 5;
    bf16x8v AH[4];
#pragma unroll
    for (int s_ = 0; s_ < 4; ++s_) AH[s_] = fr[s_];
    float gva[2][8], gvb[2][8];
#pragma unroll
    for (int nt = 0; nt < 2; ++nt) { const unsigned vo = 4u * (unsigned)(64 * w + 32 * nt + n) + 8192u * (unsigned)hi;
#pragma unroll
        for (int r = 0; r < 8; ++r) { const unsigned so = 2048u * (unsigned)((r & 3) + 8 * (r >> 2)); gva[nt][r] = bld_f32(R, vo, ga + so); gvb[nt][r] = bld_f32(R, vo, gb + so); } }
#pragma unroll
    for (int nt = 0; nt < 2; ++nt) { const int a = 64 * w + 32 * nt + n;
        f32x2 lo8[8], hx[2]; tw_cols(a, 1.f, hi, lo8, hx);
        float xr0[8], xi0[8], xr1[8], xi1[8];
#pragma unroll
        for (int j = 0; j < 8; ++j) { const f32x2 p = cmul(X[phA(a, 8 * hi + j)], (j == 0 ? hx[0] : cmul(lo8[j], hx[0]))), q = cmul(X[phA(a, 16 + 8 * hi + j)], (j == 0 ? hx[1] : cmul(lo8[j], hx[1])));
            xr0[j] = p.x; xi0[j] = p.y; xr1[j] = q.x; xi1[j] = q.y; }
        f32x16v c = {};
        c = HYM_MFMA(AH[0], pack8(xr0), c); c = HYM_MFMA(AH[1], pack8(xr1), c); c = HYM_MFMA(AH[2], pack8(xi0), c); c = HYM_MFMA(AH[3], pack8(xi1), c);
        const unsigned vo = 2u * (unsigned)a + 4096u * (unsigned)hi;
#pragma unroll
        for (int r = 0; r < 8; ++r) { const unsigned so = 1024u * (unsigned)((r & 3) + 8 * (r >> 2));
            bst_b16f(R, vo, oa + so, gva[nt][r] * (c[r] + zi[nt][r] * hb)); bst_b16f(R, vo, ob + so, gvb[nt][r] * (c[8 + r] + zi[nt][8 + r] * hb)); } }
}
#undef HYM_MFMA
}
#define F_dft ((const bf16*)(F.ws + WS_DFT))
__device__ __forceinline__ void fill_dft_table(Frame& F) {
    for (int i = F.bid * NTHR + F.tid; i < hym::T_NFRAG * 64 * 8; i += PB * NTHR) ((bf16*)(F.ws + WS_DFT))[i] = (bf16)f2bf(hym::dft_entry(i >> 9, (i >> 3) & 63, i & 7));
}
__device__ __forceinline__ void hyena_mf_filters(Frame& F, int layer, int c) {
    f32x2* X = (f32x2*)F.ldsg; const bf16* tab = F_dft;
    f32x2* KF = F_kf + (size_t)F.bid * 2 * hym::N;
    const float mind = -4.605170185988091f / 1.5f, maxd = -4.605170185988091f / 0.3f;
    const float adelta = fabsf(mind + (float)c * ((maxd - mind) / 511.0f));
    const int tid = hyf::opq(F.tid);
    { typedef short bf16x8v __attribute__((ext_vector_type(8)));
      const int lane = tid & 63, wv = tid >> 6, fr = lane & 15, fq = lane >> 4;
      bf16x8v wf0 = {0, 0, 0, 0, 0, 0, 0, 0}, wf1 = {0, 0, 0, 0, 0, 0, 0, 0};
      if (fr < 4) { const int j = (fr >> 1) * 1024 + (fr & 1) * 512 + c; const float* wp = FIN(IN_FW3) + (size_t)layer * 64 * 2048 + j;
#pragma unroll
          for (int e = 0; e < 8; ++e) { wf0[e] = (short)f2bf(wp[(size_t)(8 * fq + e) * 2048]); wf1[e] = (short)f2bf(wp[(size_t)(32 + 8 * fq + e) * 2048]); } }
      const bf16* a2b = (const bf16*)(F.ws + WS_A2B) + (size_t)layer * SEQ * 64;
      const float b3a = FIN(IN_FB3)[layer * 2048 + c], b3b = FIN(IN_FB3)[layer * 2048 + 512 + c], b3c = FIN(IN_FB3)[layer * 2048 + 1024 + c], b3d = FIN(IN_FB3)[layer * 2048 + 1536 + c];
      __syncthreads();
      if (tid == 256) X[hyf::phA(0, 16)] = (f32x2){0.f, 0.f};
#pragma unroll 8
      for (int blk = wv; blk < SEQ / 16; blk += NWAVES) { const int m = 16 * blk + fr;
          const bf16x8v a0 = *(const bf16x8v*)(a2b + (size_t)m * 64 + 8 * fq), a1 = *(const bf16x8v*)(a2b + (size_t)m * 64 + 32 + 8 * fq);
          f32x4 acc = (f32x4){0.f, 0.f, 0.f, 0.f};
          acc = __builtin_amdgcn_mfma_f32_16x16x32_bf16(wf0, a0, acc, 0, 0, 0); acc = __builtin_amdgcn_mfma_f32_16x16x32_bf16(wf1, a1, acc, 0, 0, 0);
          if (fq == 0) { const float dec = __expf(-((float)m / (float)(SEQ - 1)) * adelta);
              X[hyf::phA(m & 511, m >> 9)] = (f32x2){(acc.x + b3a) * dec, (acc.z + b3c) * dec};
              if (m >= 1) { const int p = hym::N - m; X[hyf::phA(p & 511, p >> 9)] = (f32x2){(acc.y + b3b) * dec, (acc.w + b3d) * dec}; } } } }
    { const int ln = hyf::opq(tid) & 63; hym::bf16x8v f8[8], f4[4];
      hym::ld_F32F(f8, tab, ln);
      __syncthreads();
      hym::passA_fwd_cplx(X, f8, hyf::opq(tid));
      hym::ld_C(f4, tab, ln);
      __syncthreads();
      hym::passB_fwd(X, f8, hyf::opq(tid));
      __syncthreads();
      hym::passC_store(X, f4, hyf::opq(tid)); }
    __syncthreads();
    hym::split_spectra(X, KF, KF + hym::N, hyf::opq(tid));
    asm volatile("s_waitcnt vmcnt(0)" ::: "memory");
    __syncthreads();
}
__device__ __forceinline__ void hyena_mf_data(Frame& F, int layer, int c) {
    f32x2* X = (f32x2*)F.ldsg; const bf16* tab = F_dft;
    f32x2* KF = F_kf + (size_t)F.bid * 2 * hym::N;
    const float* cw = FIN(IN_HCW) + layer * 3 * HYP; const float* cb = FIN(IN_HCB) + layer * HYP;
    const int tid = hyf::opq(F.tid); const unsigned v4 = 4u * (unsigned)tid, v2 = 2u * (unsigned)tid;
    const __amdgpu_buffer_rsrc_t R = __builtin_amdgcn_make_buffer_rsrc((void*)F.ws, 0, (unsigned)WS_END, 0x00020000);
    const unsigned Sb = (unsigned)(WS_HS + (size_t)launder_u((unsigned)F.bid) * 6 * SEQ * 4);
    const float hb0 = FIN(IN_HBIAS)[layer * 1024 + c], hb1 = FIN(IN_HBIAS)[layer * 1024 + 512 + c];
#pragma unroll 1
    for (int pr = 0; pr < 2; ++pr) {
        const unsigned oab = (unsigned)(WS_ZT + ((size_t)c * MTOT + (size_t)(2 * pr) * SEQ) * 2), obb = oab + SEQ * 2;
        { typedef unsigned v4u_a4 __attribute__((ext_vector_type(4), aligned(4)));
          v4u wq[6][4]; float cwv[3][4];
#pragma unroll
          for (int j = 0; j < 3; ++j) { const int ch = j * HYW + c; cwv[j][0] = cw[ch]; cwv[j][1] = cw[HYP + ch]; cwv[j][2] = cw[2 * HYP + ch]; cwv[j][3] = cb[ch]; }
#pragma unroll
          for (int r6 = 0; r6 < 6; ++r6) { const int ch = (r6 >> 1) * HYW + c; const bf16* up = F_hyT + (size_t)ch * MTOT + (size_t)(2 * pr + (r6 & 1)) * SEQ + 4 * tid - 2;
#pragma unroll
              for (int k = 0; k < 4; ++k) { const v4u_a4 t_ = *(const v4u_a4*)(up + 2048 * k); wq[r6][k] = (v4u){t_.x, t_.y, t_.z, t_.w}; } }
#pragma unroll
          for (int r6 = 0; r6 < 6; ++r6) { float* sp = (float*)(F.ws + WS_HS) + ((size_t)launder_u((unsigned)F.bid) * 6 + r6) * SEQ + 4 * tid;
              const float w0 = cwv[r6 >> 1][0], w1 = cwv[r6 >> 1][1], w2 = cwv[r6 >> 1][2], bb = cwv[r6 >> 1][3];
#pragma unroll
              for (int k = 0; k < 4; ++k) { const v4u p = wq[r6][k];
                  float u1 = __uint_as_float(p.x & 0xffff0000u), u6 = __uint_as_float(p.w << 16);
                  if (k == 0 && tid == 0) u1 = 0.f;
                  if (k == 3 && tid == 511) u6 = 0.f;
                  const float u2 = __uint_as_float(p.y << 16), u3 = __uint_as_float(p.y & 0xffff0000u), u4 = __uint_as_float(p.z << 16), u5 = __uint_as_float(p.z & 0xffff0000u);
                  *(f32x4*)(sp + 2048 * k) = (f32x4){w0 * u1 + w1 * u2 + w2 * u3 + bb, w0 * u2 + w1 * u3 + w2 * u4 + bb, w0 * u3 + w1 * u4 + w2 * u5 + bb, w0 * u4 + w1 * u5 + w2 * u6 + bb}; } } }
        asm volatile("s_waitcnt vmcnt(0)" ::: "memory"); __syncthreads();
        float zr[2][16];
#pragma unroll
        for (int i = 0; i < 16; ++i) { zr[0][i] = 0.f; zr[1][i] = 0.f; }
#pragma unroll 1
        for (int o = 0; o < 2; ++o) {
            const unsigned ga = Sb + (unsigned)((2 + 2 * o) * SEQ * 4), gb = ga + SEQ * 4;
            const float hb = o == 0 ? hb0 : hb1;
            { const int ln = hyf::opq(tid) & 63; hym::bf16x8v f8[8], f4[4];
              hym::ld_A(f4, tab, ln, false);
              if (o == 0) hym::passA_fwd<false>(X, f4, R, Sb, Sb + SEQ * 4, hyf::opq(tid)); else hym::passA_fwd_r(X, f4, zr, hyf::opq(tid));
              hym::ld_F32F(f8, tab, ln);
              __syncthreads();
              hym::passB_fwd(X, f8, hyf::opq(tid));
              hym::ld_C(f4, tab, ln);
              __syncthreads();
              hym::passC<true>(X, f4, KF + (size_t)o * hym::N, hyf::opq(tid));
              hym::ld_F32I(f8, tab, ln);
              __syncthreads();
              hym::passB_inv(X, f8, hyf::opq(tid));
              hym::ld_AH(f4, tab, ln);
              __syncthreads();
              if (o == 0) hym::passA_inv_gate_r(X, f4, R, Sb, Sb + SEQ * 4, ga, gb, hb, hyf::opq(tid), zr); else hym::passA_inv_gate_f(X, f4, R, ga, gb, oab, obb, hb, hyf::opq(tid), zr); }
            if (o == 0) __syncthreads();
        }
        __syncthreads();
    }
}
__device__ __forceinline__ void hyena_ctx_unit(Frame& F, int layer, int c) {
    constexpr int L = CTXL;
    float* H = (float*)F.ldsg;
    float* zb = H + 2 * (2 * L + 32);
    float* zn = zb + 4 * L;
    float* w3s = zn + 4 * L;
    const float* a2 = F_a2c;
    const float* cw = FIN(IN_HCW) + layer * 3 * HYP; const float* cb = FIN(IN_HCB) + layer * HYP;
    const float mind = -4.605170185988091f / 1.5f, maxd = -4.605170185988091f / 0.3f;
    const float adelta = fabsf(mind + (float)c * ((maxd - mind) / 511.0f));
    const int tid = F.tid;
    __syncthreads();
    if (tid < 256) { const int col = tid >> 6, k = tid & 63, j = (col >> 1) * 1024 + (col & 1) * 512 + c; w3s[tid] = FIN(IN_FW3)[((size_t)layer * 64 + k) * 2048 + j]; }
    if (tid < 64) { const int o = tid >> 5, i = tid & 31; float* Ho = H + o * (2 * L + 32); if (i < 16) Ho[i] = 0.f; else Ho[2 * L + i] = 0.f; }
    if (tid >= 64 && tid < 66) H[(tid - 64) * (2 * L + 32) + 2 * L + 15] = 0.f;
    { const float w0 = cw[c], w1 = cw[HYP + c], w2 = cw[2 * HYP + c], bb = cb[c];
#pragma unroll
      for (int q = 0; q < 2; ++q) { const int e = tid + 512 * q, b = e >> 8, t = e & 255; zb[e] = hy_short(F_hyT + (size_t)c * MTOT + NLAT + b * L, t, L, w0, w1, w2, bb); } }
    __syncthreads();
    { const int m = tid & 255, o = tid >> 8; float sf = 0.f, sb = 0.f; const float* wf = w3s + (2 * o) * 64; const float* wb = wf + 64;
#pragma unroll 16
      for (int k = 0; k < 64; ++k) { const float a = a2[(size_t)k * L + m]; sf += a * wf[k]; sb += a * wb[k]; }
      const float dec = __expf(-((float)m / (float)(L - 1)) * adelta); float* Ho = H + o * (2 * L + 32);
      Ho[L + 15 + m] = (sf + FIN(IN_FB3)[layer * 2048 + o * 1024 + c]) * dec; if (m >= 1) Ho[L + 15 - m] = (sb + FIN(IN_FB3)[layer * 2048 + o * 1024 + 512 + c]) * dec; }
    __syncthreads();
#pragma unroll
    for (int o = 0; o < 2; ++o) {
        const float* zin = o == 0 ? zb : zn; float* zout = o == 0 ? zn : zb; const float* Ho = H + o * (2 * L + 32);
        const int ch = (o + 1) * HYW + c; const float w0 = cw[ch], w1 = cw[HYP + ch], w2 = cw[2 * HYP + ch], bb = cb[ch], hb = FIN(IN_HBIAS)[layer * 1024 + o * 512 + c];
#pragma unroll
        for (int q = 0; q < 2; ++q) { const int e = tid + 512 * q, b = e >> 8, t = e & 255; float a = 0.f; const float* zi = zin + b * L;
#pragma unroll 8
            for (int sidx = 0; sidx < L; ++sidx) a += zi[sidx] * Ho[t - sidx + L + 15];
            const float xo = hy_short(F_hyT + (size_t)ch * MTOT + NLAT + b * L, t, L, w0, w1, w2, bb); const float zv = xo * (a + zi[t] * hb);
            if (o == 0) zout[e] = zv; else ((bf16*)(F.ws + WS_ZT))[(size_t)c * MTOT + NLAT + b * L + t] = (bf16)f2bf(zv); }
        __syncthreads();
    }
}
__device__ __forceinline__ void mixa_hyena(Frame& F, int layer) {
    for (int u = F.bid; u < HYW; u += F.G) { hyena_mf_filters(F, layer, u); hyena_mf_data(F, layer, u); }
}
__device__ __forceinline__ void mixa_ctx(Frame& F, int layer) {
    if (layer != 0) return;
    for (int u = F.bid; u < HYW; u += F.G) hyena_ctx_unit(F, layer, u);
}
__device__ __forceinline__ void mixa_pool(Frame& F, int layer) {
    const int ntile = (layer == 0 ? MTOT : NLAT) / 128, npool = ntile * 4;
    for (int u = F.bid; u < npool; u += F.G) pool_unit(F, layer, u >> 2, u & 3);
}

__device__ __forceinline__ float dot128(const float* qs, const bf16* krow) {
    float s = 0.f;
#pragma unroll
    for (int c = 0; c < 16; ++c) { const v4u kv = *(const v4u*)(krow + 8 * c); const f32x4 q0 = *(const f32x4*)(qs + 8 * c), q1 = *(const f32x4*)(qs + 8 * c + 4);
        s += q0.x * __uint_as_float(kv.x << 16) + q0.y * __uint_as_float(kv.x & 0xffff0000u) + q0.z * __uint_as_float(kv.y << 16) + q0.w * __uint_as_float(kv.y & 0xffff0000u)
           + q1.x * __uint_as_float(kv.z << 16) + q1.y * __uint_as_float(kv.z & 0xffff0000u) + q1.z * __uint_as_float(kv.w << 16) + q1.w * __uint_as_float(kv.w & 0xffff0000u); }
    return s;
}
__device__ __forceinline__ void attn_phase_simple(Frame& F, int layer, int row_lo) {
    const int nrows = layer == 0 ? MTOT : NLAT;
    float* qs = (float*)F.ldsg + F.wave * 768; float* ps = qs + 128;
    const int h = F.wave, kvh = h >> 2; const float sink = FIN(IN_SINK)[layer * 8 + h];
    __syncthreads();
    for (int row = row_lo + F.bid; row < nrows; row += F.G) {
        const bool cx = row >= NLAT; const int b = cx ? (row - NLAT) >> 8 : row >> 13;
        { const bf16* qp = F_proj + (size_t)row * QKVP + h * 128; qs[F.lane] = bf2f(qp[F.lane]); qs[64 + F.lane] = bf2f(qp[64 + F.lane]); }
        LDS_WAIT(); asm volatile("" ::: "memory");
        const bf16* kc = F_proj + (size_t)(NLAT + b * CTXL) * QKVP + 1024 + kvh * 128;
        float mx = sink;
        int nblk = 0, qi = 0;
        if (!cx) { const int t = row & (SEQ - 1); nblk = t >> 7; qi = t & 127; }
#pragma unroll 1
        for (int j = 0; j < 6; ++j) { float sc = -1e30f;
            if (!cx) { const int ki = F.lane + 64 * j, kpos = 128 * (nblk - 1) + ki;
                if (kpos >= 0 && kpos < SEQ && ki >= qi && ki <= qi + 256) sc = dot128(qs, F_proj + (size_t)(b * SEQ + kpos) * QKVP + 1024 + kvh * 128); }
            ps[F.lane + 64 * j] = sc; mx = fmaxf(mx, sc); }
#pragma unroll 1
        for (int j = 0; j < 4; ++j) { const float sc = dot128(qs, kc + (size_t)(F.lane + 64 * j) * QKVP); ps[384 + F.lane + 64 * j] = sc; mx = fmaxf(mx, sc); }
        mx = wave_max(mx);
        float den = 0.f;
#pragma unroll 1
        for (int j = 0; j < 10; ++j) { const float sc = ps[F.lane + 64 * j]; const float p = sc > -1e29f ? __expf(sc - mx) : 0.f; ps[F.lane + 64 * j] = p; den += p; }
        den = wave_sum(den) + __expf(sink - mx);
        LDS_WAIT(); asm volatile("" ::: "memory");
        float o0 = 0.f, o1 = 0.f;
        if (!cx) { const int klo = qi, khi = qi + 256;
#pragma unroll 4
            for (int ki = klo; ki <= khi; ++ki) { const int kpos = 128 * (nblk - 1) + ki; if (kpos < 0 || kpos >= SEQ) continue; const float p = ps[ki];
                const unsigned vv = *(const unsigned*)(F_proj + (size_t)(b * SEQ + kpos) * QKVP + 1280 + kvh * 128 + 2 * F.lane); o0 += p * __uint_as_float(vv << 16); o1 += p * __uint_as_float(vv & 0xffff0000u); } }
        { const bf16* vc = F_proj + (size_t)(NLAT + b * CTXL) * QKVP + 1280 + kvh * 128 + 2 * F.lane;
#pragma unroll 4
          for (int k = 0; k < CTXL; ++k) { const float p = ps[384 + k]; const unsigned vv = *(const unsigned*)(vc + (size_t)k * QKVP); o0 += p * __uint_as_float(vv << 16); o1 += p * __uint_as_float(vv & 0xffff0000u); } }
        const float inv = 1.0f / den;
        *(f32x2*)(F_att + (size_t)row * ATTW + h * 128 + 2 * F.lane) = (f32x2){o0 * inv, o1 * inv};
        asm volatile("" ::: "memory");
    }
}

namespace att2 {
typedef short bf16x8 __attribute__((ext_vector_type(8)));
typedef short s16x4 __attribute__((ext_vector_type(4)));
typedef float f32x16 __attribute__((ext_vector_type(16)));
typedef unsigned u32x4 __attribute__((ext_vector_type(4)));
constexpr int D = 128, QBLK = 32, KVBLK = 64, LDK = QKVP, LDO = ATTW;
constexpr float THR = 8.f, C = 1.4426950408889634f;
constexpr int SHM_V = KVBLK * D * 2, SHM_K = KVBLK * D * 2;
#define KSWZ(row, colB) ((row) * 256 + ((colB) ^ (((row) & 7) << 4)))
#define SBAR() __builtin_amdgcn_sched_barrier(0)
__device__ __forceinline__ int crow(int r, int hi) { return (r & 3) + 8 * (r >> 2) + 4 * hi; }
__device__ __forceinline__ unsigned cvtpk(float lo, float hi) { unsigned r; asm volatile("v_cvt_pk_bf16_f32 %0, %1, %2" : "=v"(r) : "v"(lo), "v"(hi)); return r; }
__device__ __forceinline__ void partialSM(f32x16& p0, f32x16& p1, float& m_reg, float& mn, float& alpha) {
  float pmax = p0[0]; for (int r = 1; r < 16; ++r) pmax = fmaxf(pmax, p0[r]); for (int r = 0; r < 16; ++r) pmax = fmaxf(pmax, p1[r]);
  { auto rr = __builtin_amdgcn_permlane32_swap(__float_as_uint(pmax), __float_as_uint(pmax), false, false);
    pmax = fmaxf(__uint_as_float(rr[0]), __uint_as_float(rr[1])); }
  if (__builtin_expect(__all(pmax - m_reg <= THR), 1)) { mn = m_reg; alpha = 1.f; }
  else { mn = fmaxf(m_reg, pmax); alpha = __builtin_amdgcn_exp2f((m_reg - mn) * C); m_reg = mn; }
  float mnC = -mn * C;
  for (int r = 0; r < 16; ++r) p0[r] = fmaf(p0[r], C, mnC); for (int r = 0; r < 16; ++r) p1[r] = fmaf(p1[r], C, mnC);
  for (int r = 0; r < 16; ++r) p0[r] = __builtin_amdgcn_exp2f(p0[r]);
}
__device__ __forceinline__ void finishSM(f32x16& p0, f32x16& p1, float alpha, float& l_reg, bf16x8& pa0, bf16x8& pa1, bf16x8& pa2, bf16x8& pa3) {
  for (int r = 0; r < 16; ++r) p1[r] = __builtin_amdgcn_exp2f(p1[r]);
  float ps = 0; for (int r = 0; r < 16; ++r) ps += p0[r]; for (int r = 0; r < 16; ++r) ps += p1[r];
  { auto rr = __builtin_amdgcn_permlane32_swap(__float_as_uint(ps), __float_as_uint(ps), false, false);
    ps = __uint_as_float(rr[0]) + __uint_as_float(rr[1]); }
  l_reg = l_reg * alpha + ps;
#define PK4(P, BASE, OUT) do { unsigned a0 = cvtpk(P[BASE + 0], P[BASE + 1]), a1 = cvtpk(P[BASE + 2], P[BASE + 3]);   \
    unsigned b0 = cvtpk(P[BASE + 4], P[BASE + 5]), b1 = cvtpk(P[BASE + 6], P[BASE + 7]);                              \
    auto r0 = __builtin_amdgcn_permlane32_swap(a0, b0, false, false); auto r1 = __builtin_amdgcn_permlane32_swap(a1, b1, false, false); \
    u32x4 w = {r0[0], r1[0], r0[1], r1[1]}; OUT = *reinterpret_cast<bf16x8*>(&w); } while (0)
  PK4(p0, 0, pa0); PK4(p0, 8, pa1); PK4(p1, 0, pa2); PK4(p1, 8, pa3);
#undef PK4
}
__device__ __forceinline__ void qkt(f32x16& p0, f32x16& p1, const char* Ks, const char* qs, int r32, int hi) {
  p0 = f32x16{}; p1 = f32x16{};
  for (int d0 = 0; d0 < 8; ++d0) { int cb = (d0 * 16 + hi * 8) * 2;
    bf16x8 b0 = *reinterpret_cast<const bf16x8*>(Ks + KSWZ(r32, cb));
    bf16x8 b1 = *reinterpret_cast<const bf16x8*>(Ks + KSWZ(32 + r32, cb));
    bf16x8 q = *reinterpret_cast<const bf16x8*>(qs + d0 * 1024);
    p0 = __builtin_amdgcn_mfma_f32_32x32x16_bf16(b0, q, p0, 0, 0, 0);
    p1 = __builtin_amdgcn_mfma_f32_32x32x16_bf16(b1, q, p1, 0, 0, 0); }
}
__device__ __forceinline__ void mask_tile(f32x16& p0, f32x16& p1, int kb, int qi, int hi) {
#pragma unroll
  for (int r = 0; r < 16; ++r) { const int k0 = kb + crow(r, hi), k1 = k0 + 32;
    if (k0 < qi || k0 > qi + 256) p0[r] = -1e30f; if (k1 < qi || k1 > qi + 256) p1[r] = -1e30f; }
}
__device__ __forceinline__ int v_st(int k, int c) { const int kk = (k & ~0xC) | ((k & 4) << 1) | ((k & 8) >> 1); return ((kk >> 3) * 4 + (c >> 5)) * 512 + ((kk & 7) * 32 + (c & 31)) * 2; }
__device__ __forceinline__ int v_rd_base(int lane) { return ((lane & 3) << 3) | (((lane >> 2) & 3) << 6) | (((lane >> 4) & 1) << 5) | (((lane >> 5) & 1) << 8); }
constexpr int v_rd_off(int d0, int ks, int half) { return d0 * 512 + ks * 4096 + half * 2048; }
template <int OFF> __device__ __forceinline__ s16x4 tr_read(int vb) {
  s16x4 r; asm volatile("ds_read_b64_tr_b16 %0, %1 offset:%2" : "=&v"(r) : "v"(vb), "i"(OFF) : "memory"); return r;
}
template <int D0> __device__ __forceinline__ void pv_one(f32x16& od, int vb, bf16x8 pa0, bf16x8 pa1, bf16x8 pa2, bf16x8 pa3) {
  const s16x4 l0 = tr_read<v_rd_off(D0, 0, 0)>(vb), h0 = tr_read<v_rd_off(D0, 0, 1)>(vb), l1 = tr_read<v_rd_off(D0, 1, 0)>(vb), h1 = tr_read<v_rd_off(D0, 1, 1)>(vb);
  const s16x4 l2 = tr_read<v_rd_off(D0, 2, 0)>(vb), h2 = tr_read<v_rd_off(D0, 2, 1)>(vb), l3 = tr_read<v_rd_off(D0, 3, 0)>(vb), h3 = tr_read<v_rd_off(D0, 3, 1)>(vb);
  asm volatile("s_waitcnt lgkmcnt(0)" ::: "memory"); SBAR();
#define PK(L, H) (bf16x8){L[0], L[1], L[2], L[3], H[0], H[1], H[2], H[3]}
  od = __builtin_amdgcn_mfma_f32_32x32x16_bf16(pa0, PK(l0, h0), od, 0, 0, 0);
  od = __builtin_amdgcn_mfma_f32_32x32x16_bf16(pa1, PK(l1, h1), od, 0, 0, 0);
  od = __builtin_amdgcn_mfma_f32_32x32x16_bf16(pa2, PK(l2, h2), od, 0, 0, 0);
  od = __builtin_amdgcn_mfma_f32_32x32x16_bf16(pa3, PK(l3, h3), od, 0, 0, 0);
#undef PK
}
__device__ __forceinline__ void pv_d0(f32x16* o, int vb, bf16x8 pa0, bf16x8 pa1, bf16x8 pa2, bf16x8 pa3) {
  pv_one<0>(o[0], vb, pa0, pa1, pa2, pa3); pv_one<1>(o[1], vb, pa0, pa1, pa2, pa3); pv_one<2>(o[2], vb, pa0, pa1, pa2, pa3); pv_one<3>(o[3], vb, pa0, pa1, pa2, pa3);
}
__device__ __forceinline__ void attn_unit(const bf16* __restrict__ proj, float* __restrict__ att, const float* __restrict__ sinks, int b, int n, int hk, int hp, bool ctxq, char* lds, int ldsoff, int tid) {
  const int wid = tid >> 6, lane = tid & 63, r32 = lane & 31, hi = lane >> 5;
  char* V_lds = lds; char* K_lds = lds + 2 * SHM_V;
  float* ws = (float*)(lds + 2 * SHM_V + 2 * SHM_K) + wid * 64; float* li_l = ws; float* al_l = ws + 32;
  const int h = 4 * hk + 2 * hp + (wid >> 2), q0 = 32 * (wid & 3), qi = q0 + r32;
  const int qrow0 = ctxq ? NLAT + b * CTXL + 128 * n + q0 : b * SEQ + 128 * n + q0;
  float m_reg = -1e30f, l_reg = 0; f32x16 o[4] = {};
  char* qr = lds + 2 * SHM_V + 2 * SHM_K + 2048 + wid * 8192 + lane * 16;
  { const bf16* Qw = proj + (size_t)(qrow0 + r32) * LDK + h * D + hi * 8;
#pragma unroll
    for (int d0 = 0; d0 < 8; ++d0) *reinterpret_cast<bf16x8*>(qr + d0 * 1024) = *reinterpret_cast<const bf16x8*>(Qw + d0 * 16); }
  const int sr = tid >> 4, sc = (tid & 15) * 8, vst0 = v_st(sr, sc), vst1 = v_st(32 + sr, sc);
  const int vb0 = ldsoff + v_rd_base(lane);
  const int lskip = (n == 0) ? 2 : 0, NT = ctxq ? 4 : 4 + 6 - ((n == 0) ? 2 : 0) - ((n == SEQ / 128 - 1) ? 2 : 0);
  const bf16* Kb = proj + 1024 + hk * D + sc; const bf16* Vb = proj + 1280 + hk * D + sc;
#define TROW(T) ((T) < 4 ? (NLAT + b * CTXL + 64 * (T)) : (b * SEQ + 128 * (n - 1) + 64 * ((T) - 4 + lskip)))
#define TKB(T) ((T) < 4 ? -1 : 64 * ((T) - 4 + lskip))
  struct { bf16x8 vs0, vs1, ks0, ks1; } sr_[2];
#define SLOAD(i, T) do { const size_t _r = (size_t)(TROW(T) + sr) * LDK; sr_[i].vs0 = *reinterpret_cast<const bf16x8*>(Vb + _r); sr_[i].vs1 = *reinterpret_cast<const bf16x8*>(Vb + _r + 32 * LDK); \
    sr_[i].ks0 = *reinterpret_cast<const bf16x8*>(Kb + _r); sr_[i].ks1 = *reinterpret_cast<const bf16x8*>(Kb + _r + 32 * LDK); } while (0)
#define SWRITE(bb, i) do { *(bf16x8*)(V_lds + (bb) * SHM_V + vst0) = sr_[i].vs0;          \
    *(bf16x8*)(V_lds + (bb) * SHM_V + vst1) = sr_[i].vs1; int kc = sc * 2;               \
    *(bf16x8*)(K_lds + (bb) * SHM_K + KSWZ(sr, kc)) = sr_[i].ks0;                       \
    *(bf16x8*)(K_lds + (bb) * SHM_K + KSWZ(32 + sr, kc)) = sr_[i].ks1; } while (0)
#define SWAIT() asm volatile("s_waitcnt vmcnt(4)" ::: "memory")
#define RESC(a) do { if (__any((a) < 1.f)) { if (hi == 0) al_l[r32] = (a); asm volatile("s_waitcnt lgkmcnt(0)" ::: "memory"); \
    for (int d = 0; d < 4; ++d) for (int r = 0; r < 16; ++r) o[d][r] *= al_l[crow(r, hi)]; } } while (0)
#define MASK(P0, P1, T) do { const int _kb = TKB(T); if (_kb >= 0 && !(_kb >= q0 + 31 && _kb + 63 <= q0 + 256)) mask_tile(P0, P1, _kb, qi, hi); } while (0)
  f32x16 pA0, pA1, pB0, pB1; float mnA, mnB, alA, alB; bf16x8 pa0, pa1, pa2, pa3;
  constexpr int SE = 0, SO = 1;
  SLOAD(SE, 0); asm volatile("s_waitcnt vmcnt(0)" ::: "memory"); SWRITE(0, SE); __syncthreads();
  qkt(pA0, pA1, K_lds, qr, r32, hi); partialSM(pA0, pA1, m_reg, mnA, alA);
  SLOAD(SO, 1); SLOAD(SE, 2);
  SWAIT(); SWRITE(1, SO); __syncthreads();
  for (int j = 1; j + 1 < NT; j += 2) {
    SBAR(); qkt(pB0, pB1, K_lds + SHM_K, qr, r32, hi); MASK(pB0, pB1, j);
    finishSM(pA0, pA1, alA, l_reg, pa0, pa1, pa2, pa3); SBAR();
    SLOAD(SO, j + 2); SBAR();
    pv_d0(o, vb0, pa0, pa1, pa2, pa3); partialSM(pB0, pB1, m_reg, mnB, alB);
    __syncthreads(); SWAIT(); SWRITE(0, SE);
    RESC(alB); __syncthreads();
    SBAR(); qkt(pA0, pA1, K_lds, qr, r32, hi); MASK(pA0, pA1, j + 1);
    finishSM(pB0, pB1, alB, l_reg, pa0, pa1, pa2, pa3); SBAR();
    if (j + 3 < NT) SLOAD(SE, j + 3); SBAR();
    pv_d0(o, vb0 + SHM_V, pa0, pa1, pa2, pa3); partialSM(pA0, pA1, m_reg, mnA, alA);
    __syncthreads(); SWAIT(); SWRITE(1, SO);
    RESC(alA); __syncthreads();
  }
  SBAR(); qkt(pB0, pB1, K_lds + SHM_K, qr, r32, hi); MASK(pB0, pB1, NT - 1);
  finishSM(pA0, pA1, alA, l_reg, pa0, pa1, pa2, pa3); SBAR();
  pv_d0(o, vb0, pa0, pa1, pa2, pa3); partialSM(pB0, pB1, m_reg, mnB, alB);
  __syncthreads(); RESC(alB);
  finishSM(pB0, pB1, alB, l_reg, pa0, pa1, pa2, pa3); SBAR();
  pv_d0(o, vb0 + SHM_V, pa0, pa1, pa2, pa3);
  l_reg += __builtin_amdgcn_exp2f((sinks[h] - m_reg) * C);
  if (hi == 0) li_l[r32] = l_reg; asm volatile("s_waitcnt lgkmcnt(0)" ::: "memory");
  float rli[16];
#pragma unroll
  for (int r = 0; r < 16; ++r) rli[r] = __builtin_amdgcn_rcpf(li_l[crow(r, hi)]);
  bf16* Ow = (bf16*)att + (size_t)qrow0 * LDO + h * D;
#pragma unroll
  for (int r = 0; r < 16; ++r) { int orow = crow(r, hi);
    for (int d0 = 0; d0 < 4; ++d0) { const float v = o[d0][r] * rli[r]; const float nbv = __int_as_float(__builtin_amdgcn_update_dpp(0, __float_as_int(v), 0xB1  , 0xF, 0xF, true)); const unsigned pkd = cvtpk(v, nbv);
      if (!(lane & 1)) *(unsigned*)(Ow + (size_t)orow * LDO + d0 * 32 + r32) = pkd; } }
  __syncthreads();
#undef SLOAD
#undef SWRITE
#undef SWAIT
#undef RESC
#undef MASK
#undef TROW
#undef TKB
}
#undef KSWZ
#undef SBAR
}
__device__ __forceinline__ void attn_phase_mfma(Frame& F, int layer) {
    constexpr int NUL = NBATCH * (SEQ / 128) * 4, NUC = NBATCH * 2 * 4;
    const int NU = NUL + (layer == 0 ? NUC : 0);
    const float* sinks = FIN(IN_SINK) + layer * 8;
    __syncthreads();
    for (int u = F.bid; u < NUL; u += F.G) { const int bn = u % (NBATCH * (SEQ / 128)), hh = u / (NBATCH * (SEQ / 128));
        att2::attn_unit(F_proj, F_att, sinks, bn / (SEQ / 128), bn % (SEQ / 128), hh >> 1, hh & 1, false, (char*)F.ldsg, (int)(uintptr_t)F.lds, F.tid); }
    for (int v = (F.bid + F.G - 32 % F.G) % F.G; v < NU - NUL; v += F.G) { const int bn = v & 7, hh = v >> 3;
        att2::attn_unit(F_proj, F_att, sinks, bn >> 1, bn & 1, hh >> 1, hh & 1, true, (char*)F.ldsg, (int)(uintptr_t)F.lds, F.tid); }
}

__device__ __forceinline__ void merge_phase(Frame& F, int layer) {
    const int ntile = (layer == 0 ? MTOT : NLAT) / 64; bf16* y = uni_h(F);
    float* zl = (float*)F.ldsg;
    const float* ga = FIN(IN_GATT) + layer * ATTW; const float* gp = FIN(IN_GPOOL) + layer * POOLW; const float* gh = FIN(IN_GHY) + layer * HYW;
    f32x4 gav[4], gpv[2]; float ghv[8];
#pragma unroll
    for (int k = 0; k < 4; ++k) gav[k] = *(const f32x4*)(ga + 256 * k + 4 * F.lane);
#pragma unroll
    for (int k = 0; k < 2; ++k) gpv[k] = *(const f32x4*)(gp + 256 * k + 4 * F.lane);
#pragma unroll
    for (int k = 0; k < 8; ++k) ghv[k] = gh[F.lane + 64 * k];
    for (int tile = F.bid; tile < ntile; tile += F.G) {
        const int row0 = tile * 64;
        __syncthreads();
        { const int tok = F.tid & 63;
#pragma unroll 16
          for (int i = 0; i < HYW / 8; ++i) { const int c = (F.tid >> 6) + 8 * i; zl[c * 65 + tok] = bf2f(((const bf16*)(F.ws + WS_ZT))[(size_t)c * MTOT + row0 + tok]); } }
        __syncthreads();
#pragma unroll 1
        for (int hq = 0; hq < 2; ++hq) {
            f32x4 av[4][4], pv[4][2];
#pragma unroll
            for (int q = 0; q < 4; ++q) { const int row = row0 + F.wave * 8 + hq * 4 + q; const bf16* ar = (const bf16*)F_att + (size_t)row * ATTW; const bf16* pr = (const bf16*)F_pool + (size_t)row * POOLW;
#pragma unroll
                for (int k = 0; k < 4; ++k) { const v2u p = *(const v2u*)(ar + 256 * k + 4 * F.lane); av[q][k] = (f32x4){__uint_as_float(p.x << 16), __uint_as_float(p.x & 0xffff0000u), __uint_as_float(p.y << 16), __uint_as_float(p.y & 0xffff0000u)}; }
#pragma unroll
                for (int k = 0; k < 2; ++k) { const v2u p = *(const v2u*)(pr + 256 * k + 4 * F.lane); pv[q][k] = (f32x4){__uint_as_float(p.x << 16), __uint_as_float(p.x & 0xffff0000u), __uint_as_float(p.y << 16), __uint_as_float(p.y & 0xffff0000u)}; } }
#pragma unroll
            for (int q = 0; q < 4; ++q) { const int tok = F.wave * 8 + hq * 4 + q, row = row0 + tok;
                { float v[8]; float ss = 0.f;
#pragma unroll
                  for (int k = 0; k < 8; ++k) { v[k] = zl[(F.lane + 64 * k) * 65 + tok]; ss += v[k] * v[k]; }
                  const float rs = rsqrtf(wave_sum(ss) * (1.0f / HYW) + EPS);
#pragma unroll
                  for (int k = 0; k < 8; ++k) { const int c = F.lane + 64 * k; y[(size_t)row * DM + 1536 + c] = (bf16)f2bf(v[k] * rs * ghv[k]); } }
                { float ss = 0.f;
#pragma unroll
                  for (int k = 0; k < 4; ++k) { const f32x4 v = av[q][k]; ss += (v.x * v.x + v.y * v.y) + (v.z * v.z + v.w * v.w); }
                  const float rs = rsqrtf(wave_sum(ss) * (1.0f / ATTW) + EPS);
#pragma unroll
                  for (int k = 0; k < 4; ++k) { const int c = 256 * k + 4 * F.lane; const f32x4 o = av[q][k] * rs * gav[k];
                      v2u w; w.x = pk2(o.x, o.y); w.y = pk2(o.z, o.w); *(v2u*)(y + (size_t)row * DM + c) = w; } }
                { float ss = 0.f;
#pragma unroll
                  for (int k = 0; k < 2; ++k) { const f32x4 v = pv[q][k]; ss += (v.x * v.x + v.y * v.y) + (v.z * v.z + v.w * v.w); }
                  const float rs = rsqrtf(wave_sum(ss) * (1.0f / POOLW) + EPS);
#pragma unroll
                  for (int k = 0; k < 2; ++k) { const int c = 256 * k + 4 * F.lane; const f32x4 o = pv[q][k] * rs * gpv[k];
                      v2u w; w.x = pk2(o.x, o.y); w.y = pk2(o.z, o.w); *(v2u*)(y + (size_t)row * DM + 1024 + c) = w; } }
            }
        }
    }
}

__device__ __forceinline__ void dispatch_phase(Frame& F) {
    LAS int* pre = (LAS int*)F.lds;
    LAS int* tot = pre + 2048;
    LAS int* est = tot + 8;
    LAS int* ex = est + 16;
    LAS int* rw = ex + 256;
    __syncthreads();
    for (int i = F.tid; i < 2048; i += NTHR) pre[i] = F_grpcnt[i];
    __syncthreads();
    if (F.tid < 8) { int s = 0; for (int g = 0; g < 256; ++g) { const int v = pre[g * 8 + F.tid]; pre[g * 8 + F.tid] = s; s += v; } tot[F.tid] = s; }
    __syncthreads();
    if (F.tid == 0) { int s = 0; for (int e = 0; e < 8; ++e) { est[e] = s * 256; s += (tot[e] + 255) >> 8; } est[8] = s * 256;
        if (F.bid == 0) { for (int e = 0; e <= 8; ++e) F_pstart[e] = est[e] >> 8; } }
    __syncthreads();
    const bf16* h2 = uni_h(F);
    for (int g = F.bid; g < NLAT / 128; g += F.G) {
        __syncthreads();
        if (F.tid < 256) ex[F.tid] = F_top_e[g * 256 + F.tid];
        __syncthreads();
        if (F.tid < 256) { const int i = F.tid >> 1, e = ex[F.tid]; int rank = 0;
            for (int j = 0; j < i; ++j) rank += (ex[2 * j] == e) + (ex[2 * j + 1] == e);
            const int row = est[e] + pre[g * 8 + e] + rank; rw[F.tid] = row; F_tokrow[g * 256 + F.tid] = row; }
        __syncthreads();
#pragma unroll 1
        for (int i0 = 0; i0 < 256 * 128; i0 += 8 * NTHR) { v4u v[8];
#pragma unroll
            for (int k = 0; k < 8; ++k) { const int idx = i0 + k * NTHR + F.tid, r = idx >> 7, ch = idx & 127; v[k] = *(const v4u*)((const unsigned char*)h2 + (size_t)(g * 128 + (r >> 1)) * DM + ch * 16); }
#pragma unroll
            for (int k = 0; k < 8; ++k) { const int idx = i0 + k * NTHR + F.tid, r = idx >> 7, ch = idx & 127; *(v4u*)((unsigned char*)F_ag + (size_t)rw[r] * DM + ch * 16) = v[k]; } }
    }
    for (int e = F.bid; e < 8; e += F.G) { const int r0 = est[e] + tot[e], r1 = est[e + 1];
        for (int idx = F.tid; idx < (r1 - r0) * 128; idx += NTHR) *(v4u*)((unsigned char*)F_ag + (size_t)(r0 + (idx >> 7)) * DM + (idx & 127) * 16) = (v4u){0u, 0u, 0u, 0u}; }
}
__device__ __forceinline__ void moe_order_init(Frame& F, MoeOrder& S, int chunk, int nN, bool first) {
    const int* ps = F_pstart; const int P = ps[8];
    S.G = F.G; S.c = F.bid; S.nN = nN; S.p_lo = chunk * MOE_CAP_PANELS; const int hi = P < (chunk + 1) * MOE_CAP_PANELS ? P : (chunk + 1) * MOE_CAP_PANELS; S.np = hi > S.p_lo ? hi - S.p_lo : 0;
    S.a_off = first ? 0 : S.p_lo; S.o_off = first ? S.p_lo : 0; S.ps = ps;
}

__device__ __forceinline__ void final_phase(Frame& F) {
    const float* g2 = F_mod + (size_t)5 * MODW + 5 * DM;
    const float* fg = FIN(IN_FINALG);
    for (int rb = (F.bid * NWAVES + F.wave) * 16; rb < NLAT; rb += F.G * NWAVES * 16) {
        const float* gp = g2 + (size_t)(rb >> 13) * MODW;
        f32x4 gg[8], fgv[8];
#pragma unroll
        for (int k = 0; k < 8; ++k) { const int c = 512 * (k >> 1) + 8 * F.lane + 4 * (k & 1); gg[k] = *(const f32x4*)(gp + c); fgv[k] = *(const f32x4*)(fg + c); }
        v4u nx[4], na[4], nb[4]; float nw0, nw1;
#define FIN_LOAD(R_) do { const int r0_ = F_tokrow[(R_) * 2], r1_ = F_tokrow[(R_) * 2 + 1]; nw0 = F_gatew[(R_) * 2]; nw1 = F_gatew[(R_) * 2 + 1]; \
        _Pragma("unroll") for (int j = 0; j < 4; ++j) { const int c = 512 * j + 8 * F.lane; nx[j] = *(const v4u*)(F_x16 + (size_t)(R_) * DM + c); na[j] = *(const v4u*)(F_ye + (size_t)r0_ * DM + c); nb[j] = *(const v4u*)(F_ye + (size_t)r1_ * DM + c); } } while (0)
        FIN_LOAD(rb);
#pragma unroll 1
        for (int r = 0; r < 16; ++r) { const int row = rb + r;
            v4u cx[4], ca[4], cbv[4]; const float w0 = nw0, w1 = nw1;
#pragma unroll
            for (int j = 0; j < 4; ++j) { cx[j] = nx[j]; ca[j] = na[j]; cbv[j] = nb[j]; }
            if (r < 15) FIN_LOAD(row + 1);
            f32x4 v[8]; float ss = 0.f;
#pragma unroll
            for (int j = 0; j < 4; ++j) {
#pragma unroll
                for (int h = 0; h < 2; ++h) { const unsigned x0 = h ? cx[j].z : cx[j].x, x1 = h ? cx[j].w : cx[j].y, a0 = h ? ca[j].z : ca[j].x, a1 = h ? ca[j].w : ca[j].y, b0 = h ? cbv[j].z : cbv[j].x, b1 = h ? cbv[j].w : cbv[j].y;
                    const f32x4 x = (f32x4){__uint_as_float(x0 << 16), __uint_as_float(x0 & 0xffff0000u), __uint_as_float(x1 << 16), __uint_as_float(x1 & 0xffff0000u)};
                    f32x4 m; m.x = w0 * __uint_as_float(a0 << 16) + w1 * __uint_as_float(b0 << 16); m.y = w0 * __uint_as_float(a0 & 0xffff0000u) + w1 * __uint_as_float(b0 & 0xffff0000u);
                    m.z = w0 * __uint_as_float(a1 << 16) + w1 * __uint_as_float(b1 << 16); m.w = w0 * __uint_as_float(a1 & 0xffff0000u) + w1 * __uint_as_float(b1 & 0xffff0000u);
                    const f32x4 y = x + gg[2 * j + h] * m; v[2 * j + h] = y; ss += (y.x * y.x + y.y * y.y) + (y.z * y.z + y.w * y.w); } }
            const float rs = rsqrtf(wave_sum(ss) * (1.0f / DM) + EPS);
            float* xr = F.out + (size_t)row * DM;
#pragma unroll
            for (int k = 0; k < 8; ++k) *(f32x4*)(xr + 512 * (k >> 1) + 8 * F.lane + 4 * (k & 1)) = v[k] * rs * fgv[k];
        }
#undef FIN_LOAD
    }
}

template <class T> __device__ __forceinline__ T* launder_ptr(T* p) {
    unsigned lo = (unsigned)(uintptr_t)p, hi = (unsigned)((uintptr_t)p >> 32);
    asm volatile("" : "+v"(lo), "+v"(hi));
    lo = __builtin_amdgcn_readfirstlane(lo); hi = __builtin_amdgcn_readfirstlane(hi);
    typedef __attribute__((address_space(1))) T GT;
    return (T*)(GT*)(((uintptr_t)hi << 32) | (uintptr_t)lo);
}
__device__ __forceinline__ unsigned launder_u(unsigned v) { asm volatile("" : "+v"(v)); return (unsigned)__builtin_amdgcn_readfirstlane(v); }
__device__ __forceinline__ void fresh(Frame& F, const Args& args, const int wave0) {
    unsigned zz = 0u; asm volatile("" : "+v"(zz));
    const int tid = (int)((launder_u((unsigned)wave0) << 6) | __builtin_amdgcn_mbcnt_hi(~0u, __builtin_amdgcn_mbcnt_lo(~0u, zz)));
    F.ws = launder_ptr(args.ws); F.out = launder_ptr(args.out);
    { unsigned long long kp = (unsigned long long)(uintptr_t)__builtin_amdgcn_kernarg_segment_ptr(); unsigned lo = (unsigned)kp, hi = (unsigned)(kp >> 32); asm volatile("" : "+v"(lo), "+v"(hi));
      lo = __builtin_amdgcn_readfirstlane(lo); hi = __builtin_amdgcn_readfirstlane(hi); F.in = (const __attribute__((address_space(4))) unsigned long long*)(((unsigned long long)hi << 32) | lo); }
    F.tid = tid; F.lane = tid & 63; F.wave = __builtin_amdgcn_readfirstlane(tid >> 6);
    F.G = (int)launder_u(gridDim.x); F.bid = (int)launder_u(blockIdx.x);
    extern __shared__ __attribute__((aligned(16))) unsigned char lds_base[];
    F.lds = (LAS unsigned char*)(uintptr_t)launder_u((unsigned)(uintptr_t)(LAS unsigned char*)lds_base); F.ldsg = (unsigned char*)F.lds;
}
constexpr int PH_PRO = 0, PH_L0 = 1, PH_PER_LAYER = 9  , PH_FF1 = 10, PH_FF2 = 11, PH_L1 = 12, PH_DISP = 21, PH_MOE = 22  , PH_FINAL = 24, NPHASE = 25;

#define IN(k) (fresh(F, args, wave0), lo <= (k) && (k) < hi)
#define REP(k) (((PROBE_MASK >> (k)) & 1u) != 0u)
#define SEAM(k) do { if (IN(k) && IN((k) + 1)) { XcdBarrier bb; bb.bar = (unsigned*)(F.ws + WS_CTL) + CW_BAR; bb.x = xb_xcc_id(); bb.st = (volatile LAS unsigned*)(F.lds + LDSCTL_OFF); xcd_barrier(bb); } } while (0)

template <int LAYER>
__device__ __forceinline__ void layer_phases(Frame& F, const Args& args, const int lo, const int hi, const int wave0) {
    constexpr int pb = LAYER == 0 ? PH_L0 : PH_L1;
    if (IN(pb + 0)) { if (LAYER == 0) norm_phase<0, false, false>(F, 0, MTOT); else norm_phase<0, false, true>(F, 1, MTOT); }
    SEAM(pb + 0);
    if (IN(pb + 1)) {
        pg8::Gemm g{LAYER == 0 ? uni_winT(F, 0) : uni_h(F), LAYER == 0 ? uni_winT(F, 0) : uni_h(F), DM};
        WinOrder S; S.init(F.G, F.bid, LAYER);
        EpiIn E{F_proj, F_hyT, F_ropec, F_ropes};
        pg8::gemm_phase<EpiIn, WinOrder, true, true>(F.lds, g, S, E, F.tid);
    }
    SEAM(pb + 1);
    if (IN(pb + 2)) mixa_hyena(F, LAYER);
    if (IN(pb + 3)) mixa_ctx(F, LAYER);
    if (IN(pb + 4)) mixa_pool(F, LAYER);
    if (IN(pb + 5)) attn_phase_mfma(F, LAYER);
    SEAM(pb + 5);
    if (IN(pb + 6)) merge_phase(F, LAYER);
    SEAM(pb + 6);
    if (IN(pb + 7)) {
        pg8::Gemm g{uni_h(F), F_woutT + (size_t)LAYER * DM * DM, DM};
        pg8::StaticOrder S; S.init(LAYER == 0 ? MTOT : NLAT, DM, F.G, F.bid);
        EpiResid<LAYER == 0> E{FIN(IN_X), FIN(IN_CTX), F_x16, F_mod + (size_t)LAYER * 5 * MODW + 2 * DM, 1.0f};
        pg8::gemm_phase<EpiResid<LAYER == 0>, pg8::StaticOrder, true, true>(F.lds, g, S, E, F.tid);
    }
    SEAM(pb + 7);
    if (IN(pb + 8)) { if (LAYER == 0) norm_phase<1, false>(F, 0, MTOT); else norm_phase<1, true>(F, 1, NLAT); }
    SEAM(pb + 8);
    if constexpr (LAYER == 0) {
        if (IN(PH_FF1)) {
            pg8::Gemm g{uni_h(F), F_ff13T, DM / 2};
            pg8::StaticOrder S; S.init(MTOT, 2 * DFF, F.G, F.bid);
            EpiSwiglu E{F_hid, 1.0f / 64.0f, 1};
            pg8::gemm_phase<EpiSwiglu, pg8::StaticOrder, true, true, true>(F.lds, g, S, E, F.tid);
        }
        SEAM(PH_FF1);
        if (IN(PH_FF2)) {
            pg8::Gemm g{F_hid, F_ff2T, DFF / 2};
            pg8::StaticOrder S; S.init(MTOT, DM, F.G, F.bid);
            EpiResid<false> E{nullptr, nullptr, F_x16, F_mod + 5 * DM, 1.0f / 64.0f};
            pg8::gemm_phase<EpiResid<false>, pg8::StaticOrder, true, true, true>(F.lds, g, S, E, F.tid);
        }
        SEAM(PH_FF2);
    }
}
template <int CK>
__device__ __forceinline__ void moe_chunk(Frame& F, const Args& args, const int lo, const int hi, const int wave0) {
    if (IN(PH_MOE + 2 * CK)) {
        pg8::Gemm g{F_ag, F_moe13T, DM / 2};
        MoeOrder S; moe_order_init(F, S, CK, 2 * DFF / 256, true);
        EpiSwiglu E{F_hid, 1.0f / 64.0f, 1};
        pg8::gemm_phase<EpiSwiglu, MoeOrder, true, true, true>(F.lds, g, S, E, F.tid);
    }
    SEAM(PH_MOE + 2 * CK);
    if (IN(PH_MOE + 2 * CK + 1)) {
        pg8::Gemm g{F_hid, F_moe2T, DFF / 2};
        MoeOrder S; moe_order_init(F, S, CK, DM / 256, false);
        EpiBf16Plain E{F_ye, DM, 1.0f / 64.0f};
        pg8::gemm_phase<EpiBf16Plain, MoeOrder, true, true, true>(F.lds, g, S, E, F.tid);
    }
    SEAM(PH_MOE + 2 * CK + 1);
}

__global__ void __launch_bounds__(NTHR, 2) fwd_kernel(Args args) {
    const int wave0 = __builtin_amdgcn_readfirstlane((int)(threadIdx.x >> 6));
    Frame F;
    fresh(F, args, wave0);
    for (int u = F.tid; u < (LDS_BYTES - LDSCTL_OFF) / 4; u += NTHR) ((LAS unsigned*)(F.lds + LDSCTL_OFF))[u] = 0u;
    __syncthreads();
    if (!MK_PER_PHASE) (void)xcd_barrier_post((unsigned*)(args.ws + WS_CTL) + CW_BAR, (volatile LAS unsigned*)(F.lds + LDSCTL_OFF));
    const int lo = args.ph_lo, hi = args.ph_hi;

    if (IN(PH_PRO) && F.bid < PB) p0_mod(F);
    if (IN(PH_PRO) && F.bid < PB) p0_tables(F);
    if (IN(PH_PRO)) p0_weights(F);
    SEAM(PH_PRO);
#ifdef PROBE_LIST
    if (IN(100)) p0_weights(F);
    if (IN(101)) p0_mod(F);
    if (IN(102)) p0_tables(F);
#endif
    layer_phases<0>(F, args, lo, hi, wave0);
    layer_phases<1>(F, args, lo, hi, wave0);
    if (IN(PH_DISP)) dispatch_phase(F);
    SEAM(PH_DISP);
    moe_chunk<0>(F, args, lo, hi, wave0);
    if (IN(PH_FINAL)) final_phase(F);
}
#undef IN
#undef SEAM

extern "C" void kernel_launch(void* const* d_in, const int* in_sizes, int n_in, void* d_out, int out_size, void* d_ws, size_t ws_size, hipStream_t stream) {
    static int grid = 0;
    if (grid == 0) {
        if (n_in != 34 || in_sizes[0] != NLAT * DM || out_size != NLAT * DM || ws_size < WS_END) {
            fprintf(stderr, "kernel_launch: shape/workspace mismatch: n_in %d in0 %d out %d ws %zu (need %zu); nothing launched\n", n_in, n_in > 0 ? in_sizes[0] : -1, out_size, ws_size, (size_t)WS_END); grid = -1; return; }
        int dev = 0, cus = 0, per_cu = 0;
        if (hipGetDevice(&dev) != hipSuccess || hipDeviceGetAttribute(&cus, hipDeviceAttributeMultiprocessorCount, dev) != hipSuccess) { grid = -1; return; }
        if (hipFuncSetAttribute((const void*)fwd_kernel, hipFuncAttributeMaxDynamicSharedMemorySize, LDS_BYTES) != hipSuccess) { fprintf(stderr, "kernel_launch: hipFuncSetAttribute failed\n"); grid = -1; return; }
        if (hipOccupancyMaxActiveBlocksPerMultiprocessor(&per_cu, (const void*)fwd_kernel, NTHR, LDS_BYTES) != hipSuccess || per_cu < 1) { fprintf(stderr, "kernel_launch: occupancy query says %d\n", per_cu); (void)hipGetLastError(); grid = -1; return; }
        grid = cus < 256 ? cus : 256;
    }
    if (grid < 0) return;
    if (hipMemsetAsync((char*)d_ws + WS_CTL, 0, CTL_ZERO_BYTES, stream) != hipSuccess) return;
    Args a{};
    for (int i = 0; i < 34; ++i) a.in[i] = (const float*)d_in[i];
    a.out = (float*)d_out; a.ws = (unsigned char*)d_ws;
#if MK_PER_PHASE
    for (int k = 0; k < NPHASE; ++k) { a.ph_lo = k; a.ph_hi = k + 1; hipLaunchKernelGGL(fwd_kernel, dim3(grid), dim3(NTHR), LDS_BYTES, stream, a); }
#else
    a.ph_lo = 0; a.ph_hi = NPHASE;
    hipLaunchKernelGGL(fwd_kernel, dim3(grid), dim3(NTHR), LDS_BYTES, stream, a);
#ifdef PROBE_LIST
    { static const int probe[][2] = {PROBE_LIST}; for (unsigned i = 0; i < sizeof(probe) / sizeof(probe[0]); ++i) { a.ph_lo = probe[i][0]; a.ph_hi = probe[i][1]; hipLaunchKernelGGL(fwd_kernel, dim3(grid), dim3(NTHR), LDS_BYTES, stream, a); } }
#endif
#endif
    const hipError_t le = hipPeekAtLastError();
    if (le != hipSuccess) fprintf(stderr, "kernel_launch: launch failed: %s\n", hipGetErrorName(le));
}
```
